# Optimizing an MI355X kernel written in HIP

```python
import math
import jax, jax.numpy as jnp
from jax import lax
import numpy as np

D_MODEL = 1024
BATCH = 8
SEQ = 2048
DEPTH = 2

N_META = 16
DN_HEADS = 4
DN_DK = 128
DN_DV = 128
DN_KEY = DN_HEADS * DN_DK
DN_VAL = DN_HEADS * DN_DV
CONV_W = 4
CHUNK = 64
SA_HEADS = 8
SA_DH = 64
SA_W = SA_HEADS * SA_DH
IDX_HEADS = 8
IDX_DH = 64
K_MAX = 256
Q_BLOCK = 128
ROPE_THETA = 10000.0
MIX_W = DN_VAL + SA_W
N_GROUPS = 4
EXP_PER_GROUP = 8
N_EXPERTS = N_GROUPS * EXP_PER_GROUP
TOP_K_IN_GROUP = 2
D_EXPERT = 256
DEEPNORM_ALPHA = (2.0 * DEPTH) ** 0.25
DEEPNORM_BETA = (8.0 * DEPTH) ** -0.25

SPLIT_SIZES = (DN_KEY, DN_KEY, DN_VAL, DN_VAL, DN_HEADS, DN_HEADS,
               SA_W, SA_W, SA_W, IDX_HEADS * IDX_DH, IDX_DH, IDX_HEADS)
SPLIT_POINTS = tuple(int(s) for s in np.cumsum(SPLIT_SIZES)[:-1])
D_IN_PROJ = int(sum(SPLIT_SIZES))
VALUE_COLS = (2, 8)

kernel_name = 'hybrid_deltanet_dsa_hmoe'

F32 = jnp.float32


def layer_norm(x, g, b, eps=1e-5):
    xf = x.astype(F32)
    mu = jnp.mean(xf, -1, keepdims=True)
    var = jnp.mean(jnp.square(xf - mu), -1, keepdims=True)
    return ((xf - mu) * lax.rsqrt(var + eps) * g + b).astype(x.dtype)


def rope_tables(n_pos, dim):
    inv = 1.0 / (ROPE_THETA ** (jnp.arange(0, dim, 2, dtype=F32) / dim))
    ang = jnp.arange(n_pos, dtype=F32)[:, None] * inv[None, :]
    ang = jnp.concatenate([ang, ang], -1)
    return jnp.cos(ang), jnp.sin(ang)


def apply_rope(x, cos, sin):
    half = x.shape[-1] // 2
    rot = jnp.concatenate([-x[..., half:], x[..., :half]], -1)
    shape = (1, cos.shape[0]) + (1,) * (x.ndim - 3) + (cos.shape[-1],)
    return (x * cos.reshape(shape) + rot * sin.reshape(shape)).astype(x.dtype)


def causal_dwconv(x, w):
    c = x.shape[-1]
    return lax.conv_general_dilated(x, w[:, None, :].astype(x.dtype), window_strides=(1,),
                                    padding=[(CONV_W - 1, 0)],
                                    dimension_numbers=('NWC', 'WIO', 'NWC'),
                                    feature_group_count=c)


def l2norm(x, eps=1e-6):
    return x * lax.rsqrt(jnp.sum(x * x, -1, keepdims=True) + eps)


def chunk_gated_delta_rule(q, k, v, g, beta):
    bsz, seq, h, dk = q.shape
    dv = v.shape[-1]
    n = seq // CHUNK

    def chunks(t):
        t = t.reshape((bsz, n, CHUNK, h) + t.shape[3:])
        return jnp.moveaxis(t, 3, 2)

    q, k, v, g, beta = (chunks(t) for t in (q, k, v, g, beta))
    q = q * dk ** -0.5
    gc = jnp.cumsum(g, axis=-1)
    pos = jnp.arange(CHUNK)
    tril = pos[:, None] >= pos[None, :]
    strict = pos[:, None] > pos[None, :]
    decay = jnp.exp(jnp.where(tril, gc[..., :, None] - gc[..., None, :], -jnp.inf))
    kb = k * beta[..., None]
    lower = jnp.where(strict, jnp.einsum('bnhid,bnhjd->bnhij', kb, k) * decay, 0.0)
    eye = jnp.eye(CHUNK, dtype=q.dtype)
    tmat = lax.linalg.triangular_solve(eye + lower, jnp.broadcast_to(eye, lower.shape),
                                       left_side=True, lower=True, unit_diagonal=True)
    u = tmat @ (v * beta[..., None])
    w = tmat @ (kb * jnp.exp(gc)[..., None])
    q_dec = q * jnp.exp(gc)[..., None]
    a_qk = jnp.where(tril, jnp.einsum('bnhid,bnhjd->bnhij', q, k) * decay, 0.0)
    g_last = gc[..., -1]
    k_dec = k * jnp.exp(g_last[..., None] - gc)[..., None]

    def step(state, inp):
        u_n, w_n, qd_n, a_n, kd_n, gl_n = inp
        v_new = u_n - jnp.einsum('bhck,bhkv->bhcv', w_n, state)
        o_n = jnp.einsum('bhck,bhkv->bhcv', qd_n, state) + jnp.einsum('bhij,bhjv->bhiv', a_n, v_new)
        state = state * jnp.exp(gl_n)[..., None, None] + jnp.einsum('bhck,bhcv->bhkv', kd_n, v_new)
        return state, o_n

    xs = tuple(jnp.moveaxis(t, 1, 0) for t in (u, w, q_dec, a_qk, k_dec, g_last))
    s0 = jnp.zeros((bsz, h, dk, dv), q.dtype)
    _, o = lax.scan(step, s0, xs)
    o = jnp.moveaxis(o, 0, 1)
    return jnp.moveaxis(o, 3, 2).reshape(bsz, seq, h, dv)


def deltanet_group(q, k, v, z, b_logit, a_logit, conv_w, a_log, dt_bias, norm_g):
    bsz, seq, _ = q.shape
    qkv = jax.nn.silu(causal_dwconv(jnp.concatenate([q, k, v], -1), conv_w)).astype(F32)
    q, k, v = jnp.split(qkv, [DN_KEY, 2 * DN_KEY], axis=-1)
    q = l2norm(q.reshape(bsz, seq, DN_HEADS, DN_DK))
    k = l2norm(k.reshape(bsz, seq, DN_HEADS, DN_DK))
    v = v.reshape(bsz, seq, DN_HEADS, DN_DV)
    beta = jax.nn.sigmoid(b_logit.astype(F32))
    g = -jnp.exp(a_log.astype(F32)) * jax.nn.softplus(a_logit.astype(F32) + dt_bias.astype(F32))
    pad = (-N_META) % CHUNK
    padf = lambda t: jnp.pad(t, ((0, 0), (pad, 0)) + ((0, 0),) * (t.ndim - 2))
    o = chunk_gated_delta_rule(padf(q), padf(k), padf(v), padf(g), padf(beta))[:, pad:]
    o = o * lax.rsqrt(jnp.mean(o * o, -1, keepdims=True) + 1e-6) * norm_g
    o = o.reshape(bsz, seq, DN_VAL) * jax.nn.silu(z.astype(F32))
    return o.astype(z.dtype)


def dsa_group(q, k, v, qi, ki, wi, cos, sin, cos_i, sin_i, k_top):
    bsz, seq, _ = q.shape
    q = apply_rope(q.reshape(bsz, seq, SA_HEADS, SA_DH), cos, sin)
    k = apply_rope(k.reshape(bsz, seq, SA_HEADS, SA_DH), cos, sin)
    v = v.reshape(bsz, seq, SA_HEADS, SA_DH)
    qi = apply_rope(qi.reshape(bsz, seq, IDX_HEADS, IDX_DH), cos_i, sin_i)
    ki = apply_rope(ki, cos_i, sin_i)
    wi = wi.astype(F32) * IDX_HEADS ** -0.5
    n_blk = -(-seq // Q_BLOCK)
    lq = n_blk * Q_BLOCK

    def blocks(t):
        t = jnp.pad(t, ((0, 0), (0, lq - seq)) + ((0, 0),) * (t.ndim - 2))
        return jnp.moveaxis(t.reshape((bsz, n_blk, Q_BLOCK) + t.shape[2:]), 1, 0)

    key_pos = jnp.arange(seq)
    q_pos = jnp.arange(lq).reshape(n_blk, Q_BLOCK)
    gather = jax.vmap(lambda arr, idx: arr[idx])

    def attend(args):
        qb, qib, wib, pos = args
        causal = key_pos[None, :] <= pos[:, None]
        rel = jax.nn.relu(jnp.einsum('bqhd,bsd->bqhs', qib, ki, preferred_element_type=F32) * IDX_DH ** -0.5)
        score = jnp.einsum('bqhs,bqh->bqs', rel, wib)
        score = jnp.where(causal[None], score, -jnp.inf)
        _, sel = lax.top_k(score, k_top)
        k_sel = gather(k, sel)
        v_sel = gather(v, sel)
        valid = sel <= pos[None, :, None]
        logits = jnp.einsum('bqhd,bqkhd->bhqk', qb, k_sel, preferred_element_type=F32) * SA_DH ** -0.5
        logits = jnp.where(valid[:, None], logits, -jnp.inf)
        p = jax.nn.softmax(logits, axis=-1)
        return jnp.einsum('bhqk,bqkhd->bqhd', p.astype(v.dtype), v_sel)

    out = lax.map(attend, (blocks(q), blocks(qi), blocks(wi), q_pos))
    return jnp.moveaxis(out, 0, 1).reshape(bsz, lq, SA_W)[:, :seq]


def hier_moe(h, w_grp, b_grp, w_rtr, b_rtr, w1, w3, w2):
    bsz, seq, d = h.shape
    t = h.reshape(-1, d)
    grp_prob = jax.nn.softmax((t @ w_grp).astype(F32) + b_grp, axis=-1)
    g_prob, g_sel = lax.top_k(grp_prob, 1)
    exp_logits = ((t @ w_rtr).astype(F32) + b_rtr).reshape(-1, N_GROUPS, EXP_PER_GROUP)
    in_grp = jnp.take_along_axis(exp_logits, g_sel[:, :, None], axis=1)[:, 0]
    e_prob, e_sel = lax.top_k(jax.nn.softmax(in_grp, axis=-1), TOP_K_IN_GROUP)
    gate = g_prob * e_prob / jnp.sum(e_prob, -1, keepdims=True)
    expert_id = g_sel * EXP_PER_GROUP + e_sel
    combine = jnp.sum(jax.nn.one_hot(expert_id, N_EXPERTS, dtype=F32) * gate[..., None], axis=1)
    hid = jax.nn.silu(jnp.einsum('td,edf->tef', t, w1)) * jnp.einsum('td,edf->tef', t, w3)
    y = jnp.einsum('tef,efd->td', hid * combine[..., None].astype(hid.dtype), w2)
    return y.reshape(bsz, seq, d)


def setup_inputs(seed: int = 0) -> dict:
    key = jax.random.key(seed)
    ks = jax.random.split(key, 20)
    nrm = lambda k, shape, s: jax.random.normal(k, shape, F32) * s
    d_sc = D_MODEL ** -0.5
    col_scale = np.concatenate([np.full((s,), DEEPNORM_BETA if i in VALUE_COLS else 1.0, np.float32)
                                for i, s in enumerate(SPLIT_SIZES)])
    dt = jnp.exp(jax.random.uniform(ks[5], (DEPTH, DN_HEADS), F32, math.log(1e-3), math.log(1e-1)))
    return {
        'x': nrm(ks[0], (BATCH, SEQ, D_MODEL), 1.0),
        'meta_tokens': nrm(ks[1], (N_META, D_MODEL), 1.0),
        'w_in': nrm(ks[2], (DEPTH, D_MODEL, D_IN_PROJ), d_sc) * jnp.asarray(col_scale),
        'conv_w': nrm(ks[3], (DEPTH, CONV_W, 2 * DN_KEY + DN_VAL), CONV_W ** -0.5),
        'a_log': jnp.log(jax.random.uniform(ks[4], (DEPTH, DN_HEADS), F32, 1.0, 16.0)),
        'dt_bias': dt + jnp.log(-jnp.expm1(-dt)),
        'dn_norm_g': 1.0 + nrm(ks[6], (DEPTH, DN_DV), 0.02),
        'w_out': nrm(ks[7], (DEPTH, MIX_W, D_MODEL), MIX_W ** -0.5 * DEEPNORM_BETA),
        'ln1_g': 1.0 + nrm(ks[8], (DEPTH, D_MODEL), 0.02),
        'ln1_b': nrm(ks[9], (DEPTH, D_MODEL), 0.02),
        'w_grp': nrm(ks[10], (DEPTH, D_MODEL, N_GROUPS), d_sc),
        'b_grp': nrm(ks[11], (DEPTH, N_GROUPS), 0.01),
        'w_rtr': nrm(ks[12], (DEPTH, D_MODEL, N_EXPERTS), d_sc),
        'b_rtr': nrm(ks[13], (DEPTH, N_EXPERTS), 0.01),
        'w1': nrm(ks[14], (DEPTH, N_EXPERTS, D_MODEL, D_EXPERT), d_sc),
        'w3': nrm(ks[15], (DEPTH, N_EXPERTS, D_MODEL, D_EXPERT), d_sc),
        'w2': nrm(ks[16], (DEPTH, N_EXPERTS, D_EXPERT, D_MODEL), D_EXPERT ** -0.5 * DEEPNORM_BETA),
        'ln2_g': 1.0 + nrm(ks[17], (DEPTH, D_MODEL), 0.02),
        'ln2_b': nrm(ks[18], (DEPTH, D_MODEL), 0.02),
    }


def reference(x, meta_tokens, w_in, conv_w, a_log, dt_bias, dn_norm_g, w_out, ln1_g, ln1_b,
              w_grp, b_grp, w_rtr, b_rtr, w1, w3, w2, ln2_g, ln2_b):
    bsz, seq, _ = x.shape
    total = seq + N_META
    k_top = min(K_MAX, seq // 4)
    meta = jnp.broadcast_to(meta_tokens[None].astype(x.dtype), (bsz, N_META, D_MODEL))
    h = jnp.concatenate([meta, x], axis=1)
    cos, sin = rope_tables(total, SA_DH)
    cos_i, sin_i = rope_tables(total, IDX_DH)
    for l in range(DEPTH):
        proj = h @ w_in[l]
        dq, dk, dv, dz, db, da, sq, sk, sv, iq, ik, iw = jnp.split(proj, SPLIT_POINTS, axis=-1)
        o_dn = deltanet_group(dq, dk, dv, dz, db, da, conv_w[l], a_log[l], dt_bias[l], dn_norm_g[l])
        o_sa = dsa_group(sq, sk, sv, iq, ik, iw, cos, sin, cos_i, sin_i, k_top)
        mix = jnp.concatenate([o_dn, o_sa.astype(o_dn.dtype)], axis=-1) @ w_out[l]
        h = layer_norm(DEEPNORM_ALPHA * h + mix, ln1_g[l], ln1_b[l])
        ffn = hier_moe(h, w_grp[l], b_grp[l], w_rtr[l], b_rtr[l], w1[l], w3[l], w2[l])
        h = layer_norm(DEEPNORM_ALPHA * h + ffn, ln2_g[l], ln2_b[l])
    return h[:, N_META:]
```

```cpp
#include <hip/hip_runtime.h>
#include <hip/hip_cooperative_groups.h>
#include <cstdio>
#include <cstdint>
#include <cmath>
namespace cg = cooperative_groups;

#define LAS __attribute__((address_space(3)))
typedef unsigned short bf16_t;
typedef short bf16x8 __attribute__((ext_vector_type(8)));
typedef float f32x16 __attribute__((ext_vector_type(16)));
typedef float f32x4 __attribute__((ext_vector_type(4)));
typedef unsigned u32x4 __attribute__((ext_vector_type(4)));
typedef unsigned u32x2 __attribute__((ext_vector_type(2)));

constexpr int D = 1024, NB = 8, SEQ = 2048, NMETA = 16, LT = SEQ + NMETA;
constexpr int NMAIN = NB * SEQ;
constexpr int NROWS = NMAIN + NMETA;
constexpr int MROWS = NMAIN + 256;
constexpr int NPROJP = 4352;
constexpr int NEXP = 32, DEXP = 256;
constexpr float ALPHA = 1.4142135623730951f;
constexpr int NTHREADS = 512;
constexpr int LDS_BYTES = 155648;

constexpr size_t MiB = 1u << 20;
constexpr size_t WS_CTL = 0;
constexpr size_t CTL_BYTES = 65536;
constexpr size_t WS_ROPE = 1 * MiB;
constexpr size_t WS_METAR = 2 * MiB;
constexpr size_t WS_PX = 3 * MiB;
constexpr size_t WS_IK = 5 * MiB;
constexpr size_t WS_MASK = 8 * MiB;
constexpr size_t WS_LIST = 13 * MiB;
constexpr size_t WS_LISTG = 16 * MiB;
constexpr size_t WS_GL = 19 * MiB;
constexpr size_t WS_RW = 19 * MiB + 65536;
constexpr size_t WS_WIN = 20 * MiB;
constexpr size_t WS_WOUT = 37 * MiB;
constexpr size_t WS_BF = 42 * MiB;
constexpr size_t WS_PROJ = 75 * MiB;
constexpr size_t WS_EO = WS_PROJ;
constexpr size_t WS_HID = WS_PROJ + 66 * MiB;
constexpr size_t WS_X = 205 * MiB;
constexpr size_t WS_END = 280 * MiB;
constexpr int MASKW = 68;
constexpr int LIST_CAP = 16400;
constexpr size_t WS_W13T = WS_X;
constexpr size_t WS_W2T = WS_X + 32 * MiB;

struct Params {
    const float* in[19];
    float* out;
    unsigned char* ws;
    float rope_inv[32];
    int ph_lo, ph_hi;
};
enum { I_X = 0, I_META, I_WIN, I_CONV, I_ALOG, I_DTB, I_DNG, I_WOUT, I_LN1G, I_LN1B, I_WGRP, I_BGRP, I_WRTR, I_BRTR, I_W1, I_W3, I_W2, I_LN2G, I_LN2B };

typedef float f32x2_t __attribute__((ext_vector_type(2))); typedef __bf16 bf16x2_t __attribute__((ext_vector_type(2)));
__device__ __forceinline__ unsigned pk2(float lo, float hi) { const f32x2_t v = {lo, hi}; const bf16x2_t b = __builtin_convertvector(v, bf16x2_t); return __builtin_bit_cast(unsigned, b); }
__device__ __forceinline__ unsigned f2bf(float f) { return pk2(f, 0.f) & 0xffffu; }
__device__ __forceinline__ float bf2f(unsigned short b) { return __builtin_bit_cast(float, (unsigned)b << 16); }

__device__ __forceinline__ float sum8_dpp(float v) {
    v += __builtin_bit_cast(float, __builtin_amdgcn_mov_dpp(__builtin_bit_cast(int, v), 0xB1, 0xf, 0xf, false));
    v += __builtin_bit_cast(float, __builtin_amdgcn_mov_dpp(__builtin_bit_cast(int, v), 0x4E, 0xf, 0xf, false));
    v += __builtin_bit_cast(float, __builtin_amdgcn_mov_dpp(__builtin_bit_cast(int, v), 0x141, 0xf, 0xf, false));
    return v;
}
__device__ __forceinline__ float silu_f(float v) { return v * __builtin_amdgcn_rcpf(1.f + __expf(-v)); }
__device__ __forceinline__ float wave_sum(float v) {
    v += __builtin_bit_cast(float, __builtin_amdgcn_mov_dpp(__builtin_bit_cast(int, v), 0xB1, 0xf, 0xf, false));
    v += __builtin_bit_cast(float, __builtin_amdgcn_mov_dpp(__builtin_bit_cast(int, v), 0x4E, 0xf, 0xf, false));
    v += __builtin_bit_cast(float, __builtin_amdgcn_mov_dpp(__builtin_bit_cast(int, v), 0x141, 0xf, 0xf, false));
    v += __builtin_bit_cast(float, __builtin_amdgcn_mov_dpp(__builtin_bit_cast(int, v), 0x140, 0xf, 0xf, false));
    const int b = __builtin_bit_cast(int, v);
    return (__builtin_bit_cast(float, __builtin_amdgcn_readlane(b, 0)) + __builtin_bit_cast(float, __builtin_amdgcn_readlane(b, 16))) + (__builtin_bit_cast(float, __builtin_amdgcn_readlane(b, 32)) + __builtin_bit_cast(float, __builtin_amdgcn_readlane(b, 48)));
}
__device__ __forceinline__ int otid() { int t = threadIdx.x; asm volatile("" : "+v"(t)); return t; }
__device__ __forceinline__ const float* inptr(const Params& p, int i) { asm volatile("" : "+s"(i)); return p.in[i]; }
__device__ __forceinline__ bf16_t* hb2_row(const Params& p, int row) { return row < NMAIN ? (bf16_t*)p.out + (size_t)row * D : (bf16_t*)(p.ws + WS_METAR) + (size_t)(row - NMAIN) * D; }
__device__ __forceinline__ bf16_t* y1_row(const Params& p, int row) { return row < NMAIN ? (bf16_t*)p.out + (size_t)(NMAIN + row) * D : (bf16_t*)(p.ws + WS_METAR + 524288) + (size_t)(row - NMAIN) * D; }
__device__ __forceinline__ f32x4 bf4(const u32x2 v) { return (f32x4){bf2f(v.x & 0xffff), bf2f(v.x >> 16), bf2f(v.y & 0xffff), bf2f(v.y >> 16)}; }

__device__ __forceinline__ int win_colmap(int np) {
    if (np < 2048) return np;
    if (np < 4160) return np + 8;
    if (np < 4168) return np - 4160 + 2048;
    if (np < 4176) return np;
    return -1;
}
template <class ColSrc>
__device__ __forceinline__ void transpose_tile(const ColSrc& cs, int ld, int k0, int n0, bf16_t* out, int Kout, LAS float* scr, int lane) {
    const float* colp = cs(n0 + (lane & 31));
#pragma unroll 8
    for (int i = 0; i < 32; ++i) { const int kk = 2 * i + (lane >> 5); scr[kk * 33 + (lane & 31)] = colp ? colp[(size_t)(k0 + kk) * ld] : 0.f; }
    asm volatile("s_waitcnt lgkmcnt(0)" ::: "memory");
    const int c = lane & 7;
#pragma unroll
    for (int j = 0; j < 4; ++j) {
        const int n = (lane >> 3) + 8 * j; const LAS float* s = scr + (8 * c) * 33 + n;
        u32x4 o; o.x = pk2(s[0 * 33], s[1 * 33]); o.y = pk2(s[2 * 33], s[3 * 33]); o.z = pk2(s[4 * 33], s[5 * 33]); o.w = pk2(s[6 * 33], s[7 * 33]);
        *(u32x4*)(out + (size_t)(n0 + n) * Kout + k0 + 8 * c) = o;
    }
    asm volatile("s_waitcnt lgkmcnt(0)" ::: "memory");
}


struct ColIdent { __device__ __forceinline__ int operator()(int n) const { return n; } };
template <class RowOf, class ColOf = ColIdent>
__device__ __forceinline__ void transpose_tile64(const float* W, int ld, int k0, int n0, bf16_t* out, int Kout, const RowOf& orow, LAS char* scr  , int lane, const ColOf& colof = ColOf()) {
    const int kr = lane >> 4, c4 = lane & 15;
    const int sc = colof(n0 + 4 * c4);
    f32x4 v[16];
#pragma unroll
    for (int i = 0; i < 16; ++i) v[i] = sc >= 0 ? *(const f32x4*)(W + (size_t)(k0 + 4 * i + kr) * ld + sc) : (f32x4){0.f, 0.f, 0.f, 0.f};
#pragma unroll
    for (int i = 0; i < 16; ++i)
#pragma unroll
        for (int e = 0; e < 4; ++e) *(LAS bf16_t*)(scr + (4 * c4 + e) * 144 + (4 * i + kr) * 2) = (bf16_t)f2bf(v[i][e]);
    asm volatile("s_waitcnt lgkmcnt(0)" ::: "memory");
#pragma unroll
    for (int j = 0; j < 8; ++j) {
        const int n = 8 * j + (lane >> 3), c = lane & 7;
        const u32x4 o = *(const LAS u32x4*)(scr + n * 144 + c * 16);
        *(u32x4*)(out + (size_t)orow(n0 + n) * Kout + k0 + 8 * c) = o;
    }
    asm volatile("s_waitcnt lgkmcnt(0)" ::: "memory");
}

__device__ __forceinline__ void phase0(const Params& p, LAS char* lds) {
    const int tid = otid(), lane = tid & 63, wid = tid >> 6;
    const int gw = blockIdx.x * 8 + wid, NGW = gridDim.x * 8;
    const float* x = inptr(p, I_X); const float* meta = inptr(p, I_META);
    bf16_t* Hb = (bf16_t*)(p.ws + WS_BF);
    for (int row = gw; row < MROWS; row += NGW) {
        const float* src = row < NMAIN ? x + (size_t)row * D : (row < NROWS ? meta + (size_t)(row - NMAIN) * D : nullptr);
        bf16_t* h2 = hb2_row(p, row);
#pragma unroll
        for (int j = 0; j < 4; ++j) {
            f32x4 v = src ? *(const f32x4*)(src + (lane + 64 * j) * 4) : (f32x4){0.f, 0.f, 0.f, 0.f};
            u32x2 o; o.x = pk2(v.x, v.y); o.y = pk2(v.z, v.w);
            *(u32x2*)(Hb + (size_t)row * D + (lane + 64 * j) * 4) = o;
            *(u32x2*)(h2 + (lane + 64 * j) * 4) = o;
        }
    }
    {
        LAS char* scr = lds + wid * 9216;
        constexpr int IT_IN = 16 * (NPROJP / 64), IT_OUT = 16 * 16, IT_L = IT_IN + IT_OUT;
        for (int it = gw; it < 2 * IT_L; it += NGW) {
            const int l = it / IT_L; int r = it % IT_L;
            if (r < IT_IN) {
                const int kb = r / (NPROJP / 64), nb = r % (NPROJP / 64);
                auto colof = [&](int np) -> int { const int cg = np & 255, lc = (np & ~255) + ((cg >> 5) & 3) * 64 + (cg >> 7) * 32 + (cg & 31); return win_colmap(lc); };
                auto orow = [&](int n) -> int { return n; };
                transpose_tile64(inptr(p, I_WIN) + (size_t)l * D * 4176, 4176, kb * 64, nb * 64, (bf16_t*)(p.ws + WS_WIN) + (size_t)l * NPROJP * D, D, orow, scr, lane, colof);
            } else {
                r -= IT_IN;
                const int kb = r >> 4, nb = r & 15;
                auto orow = [&](int n) -> int { return n; };
                transpose_tile64(inptr(p, I_WOUT) + (size_t)l * D * D, D, kb * 64, nb * 64, (bf16_t*)(p.ws + WS_WOUT) + (size_t)l * D * D, D, orow, scr, lane);
            }
        }
    }
    for (int idx = blockIdx.x * NTHREADS + tid; idx < 2 * D * 36; idx += gridDim.x * NTHREADS) {
        const int l = idx / (D * 36), r = idx % (D * 36), c = r % 36, q = r / 36, ln = q & 63, ji = q >> 6, j = ji >> 2, i = ji & 3, k = 4 * (ln + 64 * j) + i;
        ((float*)(p.ws + WS_RW))[idx] = c < 4 ? inptr(p, I_WGRP)[((size_t)l * D + k) * 4 + c] : inptr(p, I_WRTR)[((size_t)l * D + k) * 32 + (c - 4)];
    }
    float* rc = (float*)(p.ws + WS_ROPE); float* rs = rc + LT * 32;
    for (int i = blockIdx.x * NTHREADS + tid; i < LT * 32; i += gridDim.x * NTHREADS) {
        const int t = i >> 5, d = i & 31;
        const float ang = (float)t * p.rope_inv[d];
        const float k = rintf(ang * 0.15915494309189535f);
        float r = fmaf(-k, 6.2831854820251465f, ang); r = fmaf(-k, -1.7484556e-07f, r);
        rc[i] = __cosf(r); rs[i] = __sinf(r);
    }
}


constexpr int GT_PITCH = 144;
template <int MI, class ARow, class Epi>
__device__ __forceinline__ void gemm_tile(LAS char* lds, const ARow& arow, const bf16_t* __restrict__ Bt, int K, const Epi& epi) {
    constexpr int BM = 128 * MI, A_BYTES = BM * GT_PITCH, B_BYTES = 128 * GT_PITCH, STG = A_BYTES + B_BYTES;
    const int tid = otid(), lane = tid & 63, wid = tid >> 6, wm = wid >> 1, wn = wid & 1, r32 = lane & 31, hh = lane >> 5;
    const bf16_t* ap[2 * MI]; const bf16_t* bp[2];
#pragma unroll
    for (int i = 0; i < 2 * MI; ++i) { const int pi = tid + 512 * i; ap[i] = arow(pi >> 3) + (pi & 7) * 8; }
#pragma unroll
    for (int i = 0; i < 2; ++i) { const int pi = tid + 512 * i; bp[i] = Bt + (size_t)(pi >> 3) * K + (pi & 7) * 8; }
    const int wofs = (tid >> 3) * GT_PITCH + (tid & 7) * 16;
    u32x4 ra0[2 * MI], rb0[2], ra1[2 * MI], rb1[2];
    f32x16 acc[MI][2];
#pragma unroll
    for (int a = 0; a < MI; ++a)
#pragma unroll
        for (int b = 0; b < 2; ++b)
#pragma unroll
            for (int r = 0; r < 16; ++r) acc[a][b][r] = 0.f;
    const int nk = K >> 6;
#define GT_LOAD(RA, RB, kt_) do { _Pragma("unroll") for (int i = 0; i < 2 * MI; ++i) RA[i] = *(const u32x4*)(ap[i] + (kt_) * 64); _Pragma("unroll") for (int i = 0; i < 2; ++i) RB[i] = *(const u32x4*)(bp[i] + (kt_) * 64); } while (0)
#define GT_WRITE(RA, RB, st_) do { LAS char* sn_ = lds + (st_) * STG; _Pragma("unroll") for (int i = 0; i < 2 * MI; ++i) *(LAS u32x4*)(sn_ + wofs + i * 64 * GT_PITCH) = RA[i]; _Pragma("unroll") for (int i = 0; i < 2; ++i) *(LAS u32x4*)(sn_ + A_BYTES + wofs + i * 64 * GT_PITCH) = RB[i]; } while (0)
    const int aoff = (wm * 32 * MI + r32) * GT_PITCH + hh * 16, boff = A_BYTES + (wn * 64 + r32) * GT_PITCH + hh * 16;
#define GT_COMPUTE(st_) do { LAS char* st = lds + (st_) * STG; _Pragma("unroll") for (int s = 0; s < 4; ++s) { bf16x8 af[MI], bfr[2]; \
        _Pragma("unroll") for (int a = 0; a < MI; ++a) af[a] = *(const LAS bf16x8*)(st + aoff + a * 32 * GT_PITCH + s * 32); \
        _Pragma("unroll") for (int b = 0; b < 2; ++b) bfr[b] = *(const LAS bf16x8*)(st + boff + b * 32 * GT_PITCH + s * 32); \
        _Pragma("unroll") for (int a = 0; a < MI; ++a) _Pragma("unroll") for (int b = 0; b < 2; ++b) acc[a][b] = __builtin_amdgcn_mfma_f32_32x32x16_bf16(bfr[b], af[a], acc[a][b], 0, 0, 0); } } while (0)
    GT_LOAD(ra0, rb0, 0); GT_LOAD(ra1, rb1, 1);
    GT_WRITE(ra0, rb0, 0);
    __syncthreads();
    for (int kt = 0; kt < nk; kt += 2) {
        if (kt + 2 < nk) GT_LOAD(ra0, rb0, kt + 2);
        GT_COMPUTE(0);
        GT_WRITE(ra1, rb1, 1);
        __syncthreads();
        if (kt + 3 < nk) GT_LOAD(ra1, rb1, kt + 3);
        GT_COMPUTE(1);
        if (kt + 2 < nk) GT_WRITE(ra0, rb0, 0);
        __syncthreads();
    }
#undef GT_LOAD
#undef GT_WRITE
#undef GT_COMPUTE
#pragma unroll
    for (int a = 0; a < MI; ++a) epi(wm * 32 * MI + a * 32 + r32, wn * 64, acc[a][0], acc[a][1]);
}

namespace pg8 {
#define PG8_LAS __attribute__((address_space(3)))
typedef unsigned short bf16_t;
typedef short bf16x8 __attribute__((ext_vector_type(8)));
typedef float f32x4 __attribute__((ext_vector_type(4)));
typedef unsigned u32x4 __attribute__((ext_vector_type(4)));
constexpr int BM = 256, BK = 64, HALF = 128, HTB = HALF * BK * 2  , STAGE_BYTES = 8 * HTB, NXCD = 8, WGM = 8;

__host__ __device__ __forceinline__ int lds_byte(int r, int c) { const int st = (r >> 4) * 2 + (c >> 5), rr = r & 15, cc = c & 31, ob = rr * 64 + cc * 2; return st * 1024 + (ob ^ (((ob >> 9) & 1) << 5)); }
__host__ __device__ __forceinline__ void stage_rc(int b, int& R, int& C) { const int st = b / 1024, sb = b % 1024, swz = sb ^ (((sb >> 9) & 1) << 5); R = (st >> 1) * 16 + swz / 64; C = (st & 1) * 32 + (swz % 64) / 2; }
__host__ __device__ __forceinline__ int perm32(int rho) { const int n = rho >> 4, i = rho & 15; return 8 * (i >> 2) + 4 * n + (i & 3); }

struct Unit { int pm, pn; int ue = 0, um = 0; size_t bo = 0; };
struct Gemm { const bf16_t* A; const bf16_t* Bt; int M, N, K; };

struct StaticOrder {
    int nM, nN, nwg, G, c;
    __host__ __device__ void init(int M, int N, int G_, int c_) { nM = M / BM; nN = N / BM; nwg = nM * nN; G = G_; c = c_; }
    __host__ __device__ bool next(int i, Unit& u) const {
        const long L = (long)i * G + c; if (L >= nwg) return false;
        int wgid = (int)L; { const int q = nwg / NXCD, r = nwg % NXCD, xcd = wgid % NXCD, off = wgid / NXCD; wgid = (xcd < r ? xcd * (q + 1) : r * (q + 1) + (xcd - r) * q) + off; }
        const int nig = WGM * nN, gid = wgid / nig, fm = gid * WGM, gsz = (nM - fm) < WGM ? (nM - fm) : WGM;
        u.pm = fm + ((wgid % nig) % gsz); u.pn = (wgid % nig) / gsz; return true;
    }
    __device__ __forceinline__ void a_ready(const Unit&) const {}
    __device__ __forceinline__ void done(const Unit&) const {}
};


template <class Epi, class Sched, bool ALIGN_EPI = false, bool SP2 = false>
__device__ __forceinline__ void gemm_phase(PG8_LAS unsigned char* lds, const Gemm g, const Sched& S, const Epi& E) {
    const int tid = otid(), wid = __builtin_amdgcn_readfirstlane(tid >> 6), lane = tid & 63, wr = wid >> 2, wc = wid & 3, fr = lane & 15, fq = lane >> 4;
    const int K = g.K, nt = K / BK;
    unsigned voffA[2], voffB[2];
#pragma unroll
    for (int i = 0; i < 2; ++i) { int R, C; stage_rc(tid * 16 + i * 8192, R, C); const int Rb = Epi::PERM ? ((R & ~31) + perm32(R & 31)) : R;
        voffA[i] = (unsigned)(R * K + C) * 2u; voffB[i] = (unsigned)(Rb * K + C) * 2u; }
    const size_t kstep = (size_t)(BK * 2);
    const size_t hstep = (size_t)HALF * K * 2;
    const size_t tstep = 2 * hstep;
    const unsigned ldsw = (unsigned)wid * 1024u;
    const int aoff = lds_byte(wr * 64 + fr, fq * 8), boff = lds_byte(wc * 32 + fr, fq * 8);
#define PG8_SA(b, h) (((b) * 2 + (h)) * HTB)
#define PG8_SB(b, h) ((4 + (b) * 2 + (h)) * HTB)
#define PG8_STAGE(bufoff, gbase, voff) do { _Pragma("unroll") for (int _i = 0; _i < 2; ++_i) \
        __builtin_amdgcn_global_load_lds((const unsigned*)((const char*)(gbase) + (voff)[_i]), (PG8_LAS unsigned*)(lds + (bufoff) + ldsw + _i * 8192), 16, 0, 0); } while (0)
#define PG8_LDA(dst, b, h) do { _Pragma("unroll") for (int m = 0; m < 4; ++m) _Pragma("unroll") for (int k = 0; k < 2; ++k) dst[m][k] = *(const PG8_LAS bf16x8*)(lds + PG8_SA(b, h) + aoff + m * 2048 + k * 1024); } while (0)
#define PG8_LDB(dst, b, h) do { _Pragma("unroll") for (int n = 0; n < 2; ++n) _Pragma("unroll") for (int k = 0; k < 2; ++k) dst[n][k] = *(const PG8_LAS bf16x8*)(lds + PG8_SB(b, h) + boff + n * 2048 + k * 1024); } while (0)
#define PG8_MMA(ai, bj, At, Bt) do { __builtin_amdgcn_s_setprio(1); _Pragma("unroll") for (int m = 0; m < 4; ++m) _Pragma("unroll") for (int n = 0; n < 2; ++n) _Pragma("unroll") for (int k = 0; k < 2; ++k) \
        acc[ai][bj][m][n] = __builtin_amdgcn_mfma_f32_16x16x32_bf16(Bt[n][k], At[m][k], acc[ai][bj][m][n], 0, 0, 0); __builtin_amdgcn_s_setprio(0); } while (0)
#define PG8_WAIT_V(n) asm volatile("s_waitcnt vmcnt(" #n ")" ::: "memory")
#define PG8_WAIT_L(n) asm volatile("s_waitcnt lgkmcnt(" #n ")" ::: "memory")
#define PG8_BAR __builtin_amdgcn_s_barrier()
#define PG8_SCHED __builtin_amdgcn_sched_barrier(0)
    Unit cur, nxt; int ui = 0;
    if (!S.next(0, cur)) return;
    f32x4 acc[2][2][4][2];
#pragma unroll
    for (int a = 0; a < 2; ++a)
#pragma unroll
        for (int b = 0; b < 2; ++b)
#pragma unroll
            for (int m = 0; m < 4; ++m)
#pragma unroll
                for (int n = 0; n < 2; ++n) acc[a][b][m][n] = (f32x4){0.f, 0.f, 0.f, 0.f};
    bf16x8 At[4][2], B0[2][2], B1[2][2];
    const char* cA = (const char*)g.A + (size_t)cur.pm * tstep; const char* cB = (const char*)g.Bt + cur.bo + (size_t)cur.pn * tstep;
    S.a_ready(cur);
    if constexpr (SP2) {
        PG8_STAGE(PG8_SB(0, 0), cB, voffB); PG8_STAGE(PG8_SB(0, 1), cB + hstep, voffB); PG8_STAGE(PG8_SA(0, 0), cA, voffA); PG8_STAGE(PG8_SA(0, 1), cA + hstep, voffA);
        if (wr == 1) PG8_BAR;
        PG8_WAIT_V(2); PG8_BAR;
        PG8_STAGE(PG8_SB(1, 0), cB + kstep, voffB); PG8_STAGE(PG8_SA(1, 0), cA + kstep, voffA); PG8_STAGE(PG8_SB(1, 1), cB + hstep + kstep, voffB);
        PG8_WAIT_V(6); PG8_BAR;
    } else {
        PG8_STAGE(PG8_SB(0, 0), cB, voffB); PG8_STAGE(PG8_SA(0, 0), cA, voffA); PG8_STAGE(PG8_SB(0, 1), cB + hstep, voffB); PG8_STAGE(PG8_SA(0, 1), cA + hstep, voffA);
        if (wr == 1) PG8_BAR;
        PG8_WAIT_V(4); PG8_BAR;
        PG8_STAGE(PG8_SB(1, 0), cB + kstep, voffB); PG8_STAGE(PG8_SA(1, 0), cA + kstep, voffA); PG8_STAGE(PG8_SB(1, 1), cB + hstep + kstep, voffB);
        PG8_WAIT_V(6); PG8_BAR;
    }
    for (;;) {
        const bool has_next = S.next(ui + 1, nxt);
        const char* nA = has_next ? (const char*)g.A + (size_t)nxt.pm * tstep : cA; const char* nB = has_next ? (const char*)g.Bt + nxt.bo + (size_t)nxt.pn * tstep : cB;
        for (int t = 0; t < nt; t += 2) {
            const bool last = (t == nt - 2);
            const char* a1 = cA + (size_t)(t + 1) * kstep;
            const char* a2 = last ? nA : cA + (size_t)(t + 2) * kstep; const char* b2 = last ? nB : cB + (size_t)(t + 2) * kstep;
            const char* a3 = a2 + kstep; const char* b3 = b2 + kstep;
            if (last && has_next) S.a_ready(nxt);
            if constexpr (SP2) {
            PG8_LDB(B0, 0, 0); PG8_LDB(B1, 0, 1); PG8_SCHED; PG8_LDA(At, 0, 0); PG8_STAGE(PG8_SA(1, 1), a1 + hstep, voffA);
            PG8_WAIT_V(8); PG8_WAIT_L(0); PG8_BAR; PG8_MMA(0, 0, At, B0); PG8_MMA(0, 1, At, B1); PG8_BAR; PG8_SCHED;
            PG8_LDA(At, 0, 1); PG8_STAGE(PG8_SB(0, 0), b2, voffB); PG8_STAGE(PG8_SB(0, 1), b2 + hstep, voffB); PG8_STAGE(PG8_SA(0, 0), a2, voffA);
            PG8_WAIT_V(8); PG8_WAIT_L(0); PG8_BAR; PG8_MMA(1, 0, At, B0); PG8_MMA(1, 1, At, B1); PG8_BAR; PG8_SCHED;
            PG8_LDB(B0, 1, 0); PG8_LDB(B1, 1, 1); PG8_SCHED; PG8_LDA(At, 1, 0); PG8_STAGE(PG8_SA(0, 1), a2 + hstep, voffA);
            PG8_WAIT_V(8); PG8_WAIT_L(0); PG8_BAR; PG8_MMA(0, 0, At, B0); PG8_MMA(0, 1, At, B1); PG8_BAR; PG8_SCHED;
            PG8_LDA(At, 1, 1); PG8_STAGE(PG8_SB(1, 0), b3, voffB); PG8_STAGE(PG8_SB(1, 1), b3 + hstep, voffB); PG8_STAGE(PG8_SA(1, 0), a3, voffA);
            PG8_WAIT_V(8); PG8_WAIT_L(0); PG8_BAR; PG8_MMA(1, 0, At, B0); PG8_MMA(1, 1, At, B1); PG8_BAR; PG8_SCHED;
            } else {
            PG8_LDB(B0, 0, 0); PG8_SCHED; PG8_LDA(At, 0, 0); PG8_STAGE(PG8_SA(1, 1), a1 + hstep, voffA);
            PG8_WAIT_L(8); PG8_BAR; PG8_WAIT_L(0); PG8_MMA(0, 0, At, B0); PG8_BAR; PG8_SCHED;
            PG8_LDB(B1, 0, 1); PG8_STAGE(PG8_SB(0, 0), b2, voffB);
            PG8_BAR; PG8_WAIT_L(0); PG8_MMA(0, 1, At, B1); PG8_BAR;
            PG8_LDA(At, 0, 1); PG8_STAGE(PG8_SA(0, 0), a2, voffA);
            PG8_BAR; PG8_WAIT_L(0); PG8_MMA(1, 0, At, B0); PG8_BAR; PG8_SCHED;
            PG8_STAGE(PG8_SB(0, 1), b2 + hstep, voffB);
            PG8_WAIT_V(6); PG8_BAR; PG8_MMA(1, 1, At, B1); PG8_BAR;
            PG8_LDB(B0, 1, 0); PG8_SCHED; PG8_LDA(At, 1, 0); PG8_STAGE(PG8_SA(0, 1), a2 + hstep, voffA);
            PG8_WAIT_L(8); PG8_BAR; PG8_WAIT_L(0); PG8_MMA(0, 0, At, B0); PG8_BAR; PG8_SCHED;
            PG8_LDB(B1, 1, 1); PG8_STAGE(PG8_SB(1, 0), b3, voffB);
            PG8_BAR; PG8_WAIT_L(0); PG8_MMA(0, 1, At, B1); PG8_BAR;
            PG8_LDA(At, 1, 1); PG8_STAGE(PG8_SA(1, 0), a3, voffA);
            PG8_BAR; PG8_WAIT_L(0); PG8_MMA(1, 0, At, B0); PG8_BAR; PG8_SCHED;
            PG8_STAGE(PG8_SB(1, 1), b3 + hstep, voffB);
            PG8_WAIT_V(6); PG8_BAR; PG8_MMA(1, 1, At, B1); PG8_BAR;
            }
        }
        if constexpr (ALIGN_EPI) { if (wr == 0) PG8_BAR; }
        if constexpr (!Epi::AFTER_DRAIN) { E(acc, cur, wr, wc, fr, fq); S.done(cur); }
        if (!has_next) break;
#pragma unroll
        for (int a = 0; a < 2; ++a)
#pragma unroll
            for (int b = 0; b < 2; ++b)
#pragma unroll
                for (int m = 0; m < 4; ++m)
#pragma unroll
                    for (int n = 0; n < 2; ++n) acc[a][b][m][n] = (f32x4){0.f, 0.f, 0.f, 0.f};
        cur = nxt; cA = nA; cB = nB; ++ui;
        if constexpr (ALIGN_EPI) { if (wr == 1) PG8_BAR; }
    }
    PG8_WAIT_V(0);
    if constexpr (!ALIGN_EPI) { if (wr == 0) PG8_BAR; }
    PG8_BAR;
    if constexpr (Epi::AFTER_DRAIN) { E.fused(acc, cur, wr, wc, fr, fq, lds, wid, lane); S.done(cur); }
#undef PG8_SA
#undef PG8_SB
#undef PG8_STAGE
#undef PG8_LDA
#undef PG8_LDB
#undef PG8_MMA
#undef PG8_WAIT_V
#undef PG8_WAIT_L
#undef PG8_BAR
#undef PG8_SCHED
}
}

__device__ __forceinline__ void phaseG(const Params& p, int layer, int nrows, bool last) {
    const int tid = otid(), lane = tid & 63, wid = tid >> 6;
    const int gw = blockIdx.x * 8 + wid, NGW = gridDim.x * 8;
    const float* g = inptr(p, I_LN2G) + layer * D; const float* bb = inptr(p, I_LN2B) + layer * D;
    bf16_t* Hb = (bf16_t*)(p.ws + WS_BF);
    const bf16_t* EO = (const bf16_t*)(p.ws + WS_EO);
    u32x2 hn[4], e0n[4], e1n[4];
    auto pre = [&](int row) {
#pragma unroll
        for (int j = 0; j < 4; ++j) {
            hn[j] = *(const u32x2*)(Hb + (size_t)row * D + (lane + 64 * j) * 4);
            e0n[j] = *(const u32x2*)(EO + (size_t)row * D + (lane + 64 * j) * 4); e1n[j] = *(const u32x2*)(EO + (size_t)(MROWS + row) * D + (lane + 64 * j) * 4);
        }
    };
    if (gw < nrows) pre(gw);
    for (int row = gw; row < nrows; row += NGW) {
        f32x4 v[4]; float s = 0.f;
#pragma unroll
        for (int j = 0; j < 4; ++j) { v[j] = bf4(hn[j]) * ALPHA + bf4(e0n[j]) + bf4(e1n[j]); s += (v[j].x + v[j].y) + (v[j].z + v[j].w); }
        if (row + NGW < nrows) pre(row + NGW);
        const float mean = wave_sum(s) * (1.f / D); float s2 = 0.f;
#pragma unroll
        for (int j = 0; j < 4; ++j) { v[j] = v[j] - mean; s2 += (v[j].x * v[j].x + v[j].y * v[j].y) + (v[j].z * v[j].z + v[j].w * v[j].w); }
        const float rstd = 1.f / sqrtf(wave_sum(s2) * (1.f / D) + 1e-5f);
        bf16_t* h2 = hb2_row(p, row);
#pragma unroll
        for (int j = 0; j < 4; ++j) {
            const f32x4 gg = *(const f32x4*)(g + (lane + 64 * j) * 4), bv = *(const f32x4*)(bb + (lane + 64 * j) * 4);
            const f32x4 o = v[j] * rstd * gg + bv;
            if (last) *(f32x4*)(p.out + (size_t)row * D + (lane + 64 * j) * 4) = o;
            else {
                u32x2 ob; ob.x = pk2(o.x, o.y); ob.y = pk2(o.z, o.w);
                *(u32x2*)(Hb + (size_t)row * D + (lane + 64 * j) * 4) = ob;
                *(u32x2*)(h2 + (lane + 64 * j) * 4) = ob;
            }
        }
    }
}

__device__ __forceinline__ int row_pos(int row) { return row < NMAIN ? (row & (SEQ - 1)) + NMETA : (row < NROWS ? row - NMAIN : 0); }
constexpr float QSCALE = 0.125f * 1.4426950408889634f;
struct EpiInProj {
    static constexpr bool PERM = true, AFTER_DRAIN = false;
    unsigned char* ws;
    __device__ __forceinline__ void operator()(const pg8::f32x4 (&acc)[2][2][4][2], const pg8::Unit& u, int, int, int, int) const {
        const int tid_ = otid(), wid_ = __builtin_amdgcn_readfirstlane(tid_ >> 6), wr = wid_ >> 2, wc = wid_ & 3, fr = tid_ & 15, fq = (tid_ >> 4) & 3;
        const int pn = u.pn;
        bf16_t* PROJ = (bf16_t*)(ws + WS_PROJ); bf16_t* IK = (bf16_t*)(ws + WS_IK); float* PX = (float*)(ws + WS_PX); const float* rc = (const float*)(ws + WS_ROPE); const float* rs = rc + LT * 32;
        if (pn == 16 && wc >= 2) return;
#pragma unroll
        for (int ai = 0; ai < 2; ++ai)
#pragma unroll
            for (int m = 0; m < 4; ++m) {
                const int row = u.pm * 256 + ai * 128 + wr * 64 + m * 16 + fr;
                if (pn < 8 || pn == 12 || pn == 13) {
                    bf16_t* dst = PROJ + (size_t)row * 4096 + pn * 256 + wc * 64 + 8 * fq;
#pragma unroll
                    for (int bj = 0; bj < 2; ++bj) {
                        const pg8::f32x4 v0 = acc[ai][bj][m][0], v1 = acc[ai][bj][m][1];
                        *(u32x4*)(dst + 32 * bj) = (u32x4){pk2(v0[0], v0[1]), pk2(v0[2], v0[3]), pk2(v1[0], v1[1]), pk2(v1[2], v1[3])};
                    }
                } else if (pn < 16 || wc == 0) {
                    const int t = row_pos(row);
                    const float sc = pn < 10 ? QSCALE : 1.f;
                    bf16_t* dst = (pn < 16 ? PROJ + (size_t)row * 4096 + pn * 256 + wc * 64 : IK + (size_t)row * 64) + 8 * fq;
#pragma unroll
                    for (int n = 0; n < 2; ++n) {
                        const f32x4 cs = *(const f32x4*)(rc + t * 32 + 8 * fq + 4 * n), sn = *(const f32x4*)(rs + t * 32 + 8 * fq + 4 * n);
                        const pg8::f32x4 x1 = acc[ai][0][m][n], x2 = acc[ai][1][m][n];
                        const f32x4 a = (x1 * cs - x2 * sn) * sc, b = (x2 * cs + x1 * sn) * sc;
                        *(u32x2*)(dst + 4 * n) = (u32x2){pk2(a[0], a[1]), pk2(a[2], a[3])};
                        *(u32x2*)(dst + 32 + 4 * n) = (u32x2){pk2(b[0], b[1]), pk2(b[2], b[3])};
                    }
                } else if (fq < 2) {
                    float* dst = PX + (size_t)row * 16 + 8 * fq;
                    *(f32x4*)dst = acc[ai][0][m][0]; *(f32x4*)(dst + 4) = acc[ai][0][m][1];
                }
                asm volatile("" ::: "memory");
            }
    }
};
__device__ __forceinline__ void phaseA(const Params& p, int l, LAS char* lds) {
    pg8::Gemm g{(const bf16_t*)(p.ws + WS_BF), (const bf16_t*)(p.ws + WS_WIN) + (size_t)l * NPROJP * D, MROWS, NPROJP, D};
    pg8::StaticOrder S; S.init(MROWS, NPROJP, (int)gridDim.x, (int)blockIdx.x);
    EpiInProj E{p.ws};
    pg8::gemm_phase<EpiInProj, pg8::StaticOrder, true, true>((PG8_LAS unsigned char*)lds, g, S, E);
}

struct SchedCE {
    int mode; pg8::StaticOrder so; int G, c;
    __device__ __forceinline__ bool next(int i, pg8::Unit& u) const {
        if (mode == 0) return so.next(i, u);
        const LAS int* tab = (const LAS int*)(uintptr_t)131072;
        const int L = i * G + c, gt = L >> 2;
        if (gt >= tab[64]) return false;
        int lo = 0;
#pragma unroll
        for (int s = 16; s > 0; s >>= 1) if (tab[32 + lo + s] <= gt) lo += s;
        u.pm = gt; u.pn = L & 3; u.ue = lo; u.um = gt - tab[32 + lo]; u.bo = (size_t)lo * D * DEXP * 2;
        return true;
    }
    __device__ __forceinline__ void a_ready(const pg8::Unit&) const {}
    __device__ __forceinline__ void done(const pg8::Unit&) const {}
};
struct EpiCE {
    static constexpr bool PERM = true, AFTER_DRAIN = false;
    int mode; unsigned char* ws; bf16_t* dout;
    __device__ __forceinline__ void operator()(const pg8::f32x4 (&acc)[2][2][4][2], const pg8::Unit& u, int, int, int, int) const {
        const LAS int* tab = (const LAS int*)(uintptr_t)131072; const unsigned* list = (const unsigned*)(ws + WS_LIST); bf16_t* EO = (bf16_t*)(ws + WS_EO);
        const int tid_ = otid(), wid_ = __builtin_amdgcn_readfirstlane(tid_ >> 6), wr = wid_ >> 2, wc = wid_ & 3, fr = tid_ & 15, fq = (tid_ >> 4) & 3;
        const int cexp = mode ? tab[u.ue] : 0;
#pragma unroll
        for (int ai = 0; ai < 2; ++ai)
#pragma unroll
            for (int m = 0; m < 4; ++m) {
                const int rloc = ai * 128 + wr * 64 + m * 16 + fr, coff = u.pn * 256 + wc * 32 + 8 * fq;
                if (mode == 0) {
                    const size_t off = (size_t)(u.pm * 256 + rloc) * D + coff;
#pragma unroll
                    for (int bj = 0; bj < 2; ++bj) {
                        const u32x4 hv = *(const u32x4*)(dout + off + bj * 128);
                        const f32x4 y0 = bf4((u32x2){hv.x, hv.y}) * ALPHA + acc[ai][bj][m][0], y1v = bf4((u32x2){hv.z, hv.w}) * ALPHA + acc[ai][bj][m][1];
                        *(u32x4*)(dout + (size_t)NMAIN * D + off + bj * 128) = (u32x4){pk2(y0.x, y0.y), pk2(y0.z, y0.w), pk2(y1v.x, y1v.y), pk2(y1v.z, y1v.w)};
                    }
                } else {
                    const int idx = u.um * 256 + rloc;
                    if (idx < cexp) {
                        const unsigned ent = list[u.ue * LIST_CAP + idx];
                        bf16_t* dst = EO + ((size_t)(ent & 1u) * MROWS + (ent >> 1)) * D + coff;
#pragma unroll
                        for (int bj = 0; bj < 2; ++bj) {
                            const pg8::f32x4 v0 = acc[ai][bj][m][0], v1 = acc[ai][bj][m][1];
                            *(u32x4*)(dst + 128 * bj) = (u32x4){pk2(v0[0], v0[1]), pk2(v0[2], v0[3]), pk2(v1[0], v1[1]), pk2(v1[2], v1[3])};
                        }
                    }
                }
                asm volatile("" ::: "memory");
            }
    }
};
constexpr int MOE_TAB_EARLY = 131072;
__device__ __forceinline__ void moe_build_table(const unsigned* cnt, LAS int* tab);
__device__ __forceinline__ void phaseCE(const Params& p, int l, LAS char* lds, int mode) {
    const int tid = otid(), lane = tid & 63, wid = tid >> 6;
    const bf16_t* MIX = (const bf16_t*)(p.ws + WS_BF);
    const bf16_t* Wt = (const bf16_t*)(p.ws + WS_WOUT) + (size_t)l * D * D;
    {
        LAS int* tab = (LAS int*)(lds + MOE_TAB_EARLY);
        if (mode) moe_build_table((const unsigned*)(p.ws + WS_CTL) + 256 + l * 64, tab);
        pg8::Gemm g{mode ? (const bf16_t*)(p.ws + WS_HID) : MIX, mode ? (const bf16_t*)(p.ws + WS_W2T) : Wt, mode ? 0 : NMAIN, D, mode ? DEXP : D};
        SchedCE S; S.mode = mode; S.so.init(NMAIN, D, (int)gridDim.x, (int)blockIdx.x); S.G = (int)gridDim.x; S.c = (int)blockIdx.x;
        EpiCE E{mode, p.ws, (bf16_t*)p.out};
        pg8::gemm_phase<EpiCE, SchedCE, true, true>((PG8_LAS unsigned char*)lds, g, S, E);
    }
    if (mode) return;
    if (l == 0 && wid == 0 && blockIdx.x < 64) {
        typedef float f32x4v __attribute__((ext_vector_type(4)));
        const int n0 = blockIdx.x * 16, r16 = lane & 15, q = lane >> 4;
        const bf16_t* ar = MIX + (size_t)(NMAIN + r16) * D + 8 * q; const bf16_t* br = Wt + (size_t)(n0 + r16) * D + 8 * q;
        f32x4v acc = (f32x4v){0.f, 0.f, 0.f, 0.f};
        for (int s = 0; s < 32; ++s) { const bf16x8 a = *(const bf16x8*)(ar + 32 * s), bq = *(const bf16x8*)(br + 32 * s); acc = __builtin_amdgcn_mfma_f32_16x16x32_bf16(bq, a, acc, 0, 0, 0); }
        const size_t moff = (size_t)r16 * D + n0 + 4 * q;
        const f32x4 y = bf4(*(const u32x2*)(hb2_row(p, NMAIN) + moff)) * ALPHA + (f32x4){acc[0], acc[1], acc[2], acc[3]};
        *(u32x2*)(y1_row(p, NMAIN) + moff) = (u32x2){pk2(y.x, y.y), pk2(y.z, y.w)};
    }
}


__device__ __forceinline__ void mm16_acc(float (&c)[4], const LAS float* A, int pa, const LAS float* B, int pb, int lane) {
    const int r0 = 4 * (lane >> 4), cc = lane & 15;
    float bc[16];
#pragma unroll
    for (int k = 0; k < 16; ++k) bc[k] = B[k * pb + cc];
#pragma unroll
    for (int r = 0; r < 4; ++r) {
        const LAS float* ar = A + (r0 + r) * pa;
        const f32x4 a0 = *(const LAS f32x4*)ar, a1 = *(const LAS f32x4*)(ar + 4), a2 = *(const LAS f32x4*)(ar + 8), a3 = *(const LAS f32x4*)(ar + 12);
        c[r] += (a0.x * bc[0] + a0.y * bc[1] + a0.z * bc[2] + a0.w * bc[3]) + (a1.x * bc[4] + a1.y * bc[5] + a1.z * bc[6] + a1.w * bc[7])
              + (a2.x * bc[8] + a2.y * bc[9] + a2.z * bc[10] + a2.w * bc[11]) + (a3.x * bc[12] + a3.y * bc[13] + a3.z * bc[14] + a3.w * bc[15]);
    }
}
__device__ __forceinline__ void mm16_store(const float (&c)[4], float sgn, LAS float* Dst, int pd, int lane) {
    const int r0 = 4 * (lane >> 4), cc = lane & 15;
#pragma unroll
    for (int r = 0; r < 4; ++r) Dst[(r0 + r) * pd + cc] = sgn * c[r];
}
__device__ __forceinline__ int tok_row(int b, int t) { return t < NMETA ? NMAIN + t : b * SEQ + (t - NMETA); }
constexpr int DN_ITEM_BYTES = 73728;
constexpr int DN_W = 0, DN_QD = 16384, DN_KDT = 32768, DN_U = 49152, DN_AQK = 65536;
constexpr int DL_KB = 0, DL_KN = 17408, DL_QS = 34816, DL_VBT = 52224, DL_KBDT = 70656, DL_A = 89088, DL_THI = 106496, DL_TLO = 115712, DL_TF = 124928, DL_BETA = 142336, DL_GC = 142592, DL_CW = 142848  , DL_RAW = 89088  ;
__device__ __forceinline__ void dn_intra_item(const Params& p, int l, int item, LAS char* lds) {
    const int tid = otid(), lane = tid & 63, wid = tid >> 6, r32 = lane & 31, hh = lane >> 5;
    const int n = item % 33, bh = item / 33, h = bh & 3, b = bh >> 2;
    const bf16_t* PROJ = (const bf16_t*)(p.ws + WS_PROJ); const float* PX = (const float*)(p.ws + WS_PX);
    unsigned char* ib = p.ws + WS_X + (size_t)item * DN_ITEM_BYTES;
    LAS float* Lbeta = (LAS float*)(lds + DL_BETA); LAS float* Lgc = (LAS float*)(lds + DL_GC);
    if (wid == 0) {
        const int t = (n == 0) ? lane - 48 : NMETA + 64 * (n - 1) + lane; const bool valid = t >= 0;
        const int row = valid ? tok_row(b, t) : 0;
        const float bl = PX[row * 16 + h], al = PX[row * 16 + 4 + h];
        const float beta = valid ? 1.f / (1.f + __expf(-bl)) : 0.f;
        const float x = al + inptr(p, I_DTB)[l * 4 + h]; const float ex = __expf(x); const float sp = x > 20.f ? x : (ex < 0.01f ? ex * (1.f - ex * (0.5f - ex * 0.33333334f)) : __logf(1.f + ex));
        const float g = valid ? -__expf(inptr(p, I_ALOG)[l * 4 + h]) * sp : 0.f;
        float gc = g;
#pragma unroll
        for (int o = 1; o < 64; o <<= 1) { const float y = __shfl_up(gc, o); if (lane >= o) gc += y; }
        Lbeta[lane] = beta; Lgc[lane] = gc;
        if (lane == 63) ((float*)(p.ws + WS_GL))[item] = gc;
    }
    {
        const int tfirst = (n == 0) ? -48 : NMETA + 64 * (n - 1);
        u32x4 rr[7];
#pragma unroll
        for (int k = 0; k < 7; ++k) {
            const int pi = tid + 512 * k, r = pi / 48, c = pi % 48, t = tfirst - 3 + r;
            rr[k] = (pi < 67 * 48 && t >= 0) ? *(const u32x4*)(PROJ + (size_t)tok_row(b, t) * 4096 + (c >> 4) * 512 + h * 128 + (c & 15) * 8) : (u32x4){0u, 0u, 0u, 0u};
        }
        f32x4 wv = (f32x4){0.f, 0.f, 0.f, 0.f};
        if (tid < 384) { const int j = tid / 96, c4 = tid % 96; wv = *(const f32x4*)(inptr(p, I_CONV) + ((size_t)l * 4 + j) * 1536 + (c4 >> 5) * 512 + h * 128 + (c4 & 31) * 4); }
#pragma unroll
        for (int k = 0; k < 7; ++k) { const int pi = tid + 512 * k, r = pi / 48, c = pi % 48; if (pi < 67 * 48) *(LAS u32x4*)(lds + DL_RAW + r * 784 + ((c >> 4) * 128 + (c & 15) * 8) * 2) = rr[k]; }
        if (tid < 384) { const int j = tid / 96, c4 = tid % 96; *(LAS f32x4*)(lds + DL_CW + (j * 384 + (c4 >> 5) * 128 + (c4 & 31) * 4) * 4) = wv; }
    }
    __syncthreads();
    {
        const int i = tid >> 3, part = tid & 7;
        const float beta = Lbeta[i], gc = Lgc[i], gl = Lgc[63];
        const float eg = __expf(gc), egl = __expf(gl - gc);
        auto conv = [&](int ten, float (&y)[16]) {
#pragma unroll
            for (int e = 0; e < 16; ++e) y[e] = 0.f;
#pragma unroll
            for (int j = 0; j < 4; ++j) {
                const LAS char* rp = lds + DL_RAW + (i + j) * 784 + (ten * 128 + 16 * part) * 2;
                const u32x4 d0 = *(const LAS u32x4*)rp, d1 = *(const LAS u32x4*)(rp + 16);
                const LAS float* wj = (const LAS float*)(lds + DL_CW) + j * 384 + ten * 128 + 16 * part;
#pragma unroll
                for (int e4 = 0; e4 < 4; ++e4) {
                    const f32x4 w = *(const LAS f32x4*)(wj + 4 * e4);
                    const unsigned lo = e4 < 2 ? d0[2 * e4] : d1[2 * e4 - 4], hi = e4 < 2 ? d0[2 * e4 + 1] : d1[2 * e4 - 3];
                    y[4 * e4 + 0] += w.x * bf2f(lo & 0xffff); y[4 * e4 + 1] += w.y * bf2f(lo >> 16);
                    y[4 * e4 + 2] += w.z * bf2f(hi & 0xffff); y[4 * e4 + 3] += w.w * bf2f(hi >> 16);
                }
            }
#pragma unroll
            for (int e = 0; e < 16; ++e) y[e] = silu_f(y[e]);
        };
        {
            const int t = (n == 0) ? i - 48 : NMETA + 64 * (n - 1) + i;
            if (t >= 0 && (n > 0 || b == 0)) {
                bf16_t* zp = (bf16_t*)(p.ws + WS_PROJ) + (size_t)tok_row(b, t) * 4096 + 1536 + h * 128 + 16 * part;
                const float* ng = inptr(p, I_DNG) + l * 128 + 16 * part;
                const u32x4 z0 = *(const u32x4*)zp, z1 = *(const u32x4*)(zp + 8);
                unsigned po[8];
#pragma unroll
                for (int e = 0; e < 8; ++e) {
                    const unsigned zz = e < 4 ? z0[e] : z1[e - 4];
                    const float za = bf2f(zz & 0xffff), zb = bf2f(zz >> 16);
                    po[e] = pk2(ng[2 * e] * silu_f(za), ng[2 * e + 1] * silu_f(zb));
                }
                *(u32x4*)zp = (u32x4){po[0], po[1], po[2], po[3]}; *(u32x4*)(zp + 8) = (u32x4){po[4], po[5], po[6], po[7]};
            }
        }
        {
            float y[16]; conv(2, y);
#pragma unroll
            for (int e = 0; e < 16; ++e) *(LAS bf16_t*)(lds + DL_VBT + (16 * part + e) * 144 + i * 2) = (bf16_t)f2bf(y[e] * beta);
        }
        {
            float y[16]; conv(0, y);
            float sq = 0.f;
#pragma unroll
            for (int e = 0; e < 16; ++e) sq += y[e] * y[e];
            sq = sum8_dpp(sq);
            const float rq = rsqrtf(sq + 1e-6f) * 0.08838834764831845f;
            unsigned pq[8], pqd[8];
#pragma unroll
            for (int e = 0; e < 8; ++e) { const float q0 = y[2 * e] * rq, q1 = y[2 * e + 1] * rq; pq[e] = pk2(q0, q1); pqd[e] = pk2(q0 * eg, q1 * eg); }
            *(LAS u32x4*)(lds + DL_QS + i * 272 + part * 32) = (u32x4){pq[0], pq[1], pq[2], pq[3]}; *(LAS u32x4*)(lds + DL_QS + i * 272 + part * 32 + 16) = (u32x4){pq[4], pq[5], pq[6], pq[7]};
            bf16_t* QD = (bf16_t*)(ib + DN_QD) + i * 128 + part * 16;
            *(u32x4*)QD = (u32x4){pqd[0], pqd[1], pqd[2], pqd[3]}; *(u32x4*)(QD + 8) = (u32x4){pqd[4], pqd[5], pqd[6], pqd[7]};
        }
        {
            float y[16]; conv(1, y);
            float sk = 0.f;
#pragma unroll
            for (int e = 0; e < 16; ++e) sk += y[e] * y[e];
            sk = sum8_dpp(sk);
            const float rk = rsqrtf(sk + 1e-6f);
            unsigned pk[8], pkb[8];
#pragma unroll
            for (int e = 0; e < 8; ++e) { const float k0 = y[2 * e] * rk, k1 = y[2 * e + 1] * rk; pk[e] = pk2(k0, k1); pkb[e] = pk2(k0 * beta, k1 * beta); }
            *(LAS u32x4*)(lds + DL_KN + i * 272 + part * 32) = (u32x4){pk[0], pk[1], pk[2], pk[3]}; *(LAS u32x4*)(lds + DL_KN + i * 272 + part * 32 + 16) = (u32x4){pk[4], pk[5], pk[6], pk[7]};
            *(LAS u32x4*)(lds + DL_KB + i * 272 + part * 32) = (u32x4){pkb[0], pkb[1], pkb[2], pkb[3]}; *(LAS u32x4*)(lds + DL_KB + i * 272 + part * 32 + 16) = (u32x4){pkb[4], pkb[5], pkb[6], pkb[7]};
            bf16_t* KDT = (bf16_t*)(ib + DN_KDT);
#pragma unroll
            for (int e = 0; e < 16; ++e) {
                const int c = 16 * part + e; const float kn = y[e] * rk;
                *(LAS bf16_t*)(lds + DL_KBDT + c * 144 + i * 2) = (bf16_t)f2bf(kn * beta * eg);
                KDT[c * 64 + i] = (bf16_t)f2bf(kn * egl);
            }
        }
    }
    __syncthreads();
    {
        const int mat = wid >> 2, mb = (wid >> 1) & 1, nb = wid & 1;
        f32x16 acc;
#pragma unroll
        for (int r = 0; r < 16; ++r) acc[r] = 0.f;
        if (mb >= nb) {
            LAS char* ab = lds + (mat ? DL_QS : DL_KB) + (32 * mb + r32) * 272 + 16 * hh; LAS char* bb = lds + DL_KN + (32 * nb + r32) * 272 + 16 * hh;
#pragma unroll
            for (int s = 0; s < 8; ++s) acc = __builtin_amdgcn_mfma_f32_32x32x16_bf16(*(const LAS bf16x8*)(bb + 32 * s), *(const LAS bf16x8*)(ab + 32 * s), acc, 0, 0, 0);
        }
        const int i = 32 * mb + r32; const float gi = Lgc[i];
#pragma unroll
        for (int g = 0; g < 4; ++g) {
            const int j0 = 32 * nb + 8 * g + 4 * hh; const f32x4 gj = *(const LAS f32x4*)(Lgc + j0);
            float v[4];
#pragma unroll
            for (int jj = 0; jj < 4; ++jj) { const int j = j0 + jj; const bool keep = mat ? (i >= j) : (i > j); v[jj] = keep ? acc[4 * g + jj] * __expf(gi - gj[jj]) : 0.f; }
            if (mat == 0) *(LAS f32x4*)(lds + DL_A + i * 272 + j0 * 4) = (f32x4){v[0], v[1], v[2], v[3]};
            else { u32x2 o; o.x = pk2(v[0], v[1]); o.y = pk2(v[2], v[3]); *(u32x2*)((bf16_t*)(ib + DN_AQK) + i * 64 + j0) = o; }
        }
    }
    __syncthreads();
    {
        const LAS float* A = (const LAS float*)(lds + DL_A); LAS float* TF = (LAS float*)(lds + DL_TF);
        LAS float* XT = (LAS float*)(lds + DL_THI);
        if (wid == 0) {
            const int blk = lane >> 4, c = lane & 15;
            f32x4 ad[16][4];
#pragma unroll
            for (int ii = 1; ii < 16; ++ii)
#pragma unroll
                for (int c4 = 0; c4 < 4; ++c4) if (4 * c4 < ii) ad[ii][c4] = *(const LAS f32x4*)(A + (16 * blk + ii) * 68 + 16 * blk + 4 * c4);
            float t[16];
#pragma unroll
            for (int ii = 0; ii < 16; ++ii) {
                float acc = (c == ii) ? 1.f : 0.f;
#pragma unroll
                for (int jj = 0; jj < ii; ++jj) acc -= ad[ii][jj >> 2][jj & 3] * t[jj];
                t[ii] = acc;
            }
#pragma unroll
            for (int ii = 0; ii < 16; ++ii) TF[(16 * blk + ii) * 68 + 16 * blk + c] = t[ii];
        }
        __syncthreads();
#define BLK(M, i, j) ((M) + (16 * (i)) * 68 + 16 * (j))
        if (wid < 3) { float c[4] = {0.f, 0.f, 0.f, 0.f}; mm16_acc(c, BLK(A, wid + 1, wid), 68, BLK(TF, wid, wid), 68, lane); mm16_store(c, 1.f, XT + wid * 320, 20, lane); }
        __syncthreads();
        if (wid < 3) { float c[4] = {0.f, 0.f, 0.f, 0.f}; mm16_acc(c, BLK(TF, wid + 1, wid + 1), 68, XT + wid * 320, 20, lane); mm16_store(c, -1.f, BLK(TF, wid + 1, wid), 68, lane); }
        __syncthreads();
        if (wid < 2) { float c[4] = {0.f, 0.f, 0.f, 0.f}; mm16_acc(c, BLK(A, wid + 2, wid), 68, BLK(TF, wid, wid), 68, lane); mm16_acc(c, BLK(A, wid + 2, wid + 1), 68, BLK(TF, wid + 1, wid), 68, lane); mm16_store(c, 1.f, XT + wid * 320, 20, lane); }
        __syncthreads();
        if (wid < 2) { float c[4] = {0.f, 0.f, 0.f, 0.f}; mm16_acc(c, BLK(TF, wid + 2, wid + 2), 68, XT + wid * 320, 20, lane); mm16_store(c, -1.f, BLK(TF, wid + 2, wid), 68, lane); }
        __syncthreads();
        if (wid == 0) { float c[4] = {0.f, 0.f, 0.f, 0.f}; mm16_acc(c, BLK(A, 3, 0), 68, BLK(TF, 0, 0), 68, lane); mm16_acc(c, BLK(A, 3, 1), 68, BLK(TF, 1, 0), 68, lane); mm16_acc(c, BLK(A, 3, 2), 68, BLK(TF, 2, 0), 68, lane); mm16_store(c, 1.f, XT, 20, lane); }
        __syncthreads();
        if (wid == 0) { float c[4] = {0.f, 0.f, 0.f, 0.f}; mm16_acc(c, BLK(TF, 3, 3), 68, XT, 20, lane); mm16_store(c, -1.f, BLK(TF, 3, 0), 68, lane); }
#undef BLK
    }
    __syncthreads();
    {
        const int i = tid >> 3, c0 = (tid & 7) * 8;
        const f32x4 a = *(const LAS f32x4*)(lds + DL_TF + (i * 68 + c0) * 4), c = *(const LAS f32x4*)(lds + DL_TF + (i * 68 + c0 + 4) * 4);
        const bool up = (c0 >> 4) > (i >> 4);
        const float v[8] = {up ? 0.f : a.x, up ? 0.f : a.y, up ? 0.f : a.z, up ? 0.f : a.w, up ? 0.f : c.x, up ? 0.f : c.y, up ? 0.f : c.z, up ? 0.f : c.w};
        unsigned hi[8]; float lo[8];
#pragma unroll
        for (int e = 0; e < 8; ++e) { hi[e] = f2bf(v[e]); lo[e] = v[e] - bf2f((unsigned short)hi[e]); }
        *(LAS u32x4*)(lds + DL_THI + i * 144 + c0 * 2) = (u32x4){hi[0] | (hi[1] << 16), hi[2] | (hi[3] << 16), hi[4] | (hi[5] << 16), hi[6] | (hi[7] << 16)};
        *(LAS u32x4*)(lds + DL_TLO + i * 144 + c0 * 2) = (u32x4){pk2(lo[0], lo[1]), pk2(lo[2], lo[3]), pk2(lo[4], lo[5]), pk2(lo[6], lo[7])};
    }
    __syncthreads();
    {
        const int mb = wid >> 2, nb = wid & 3;
        LAS char* th = lds + DL_THI + (32 * mb + r32) * 144 + 16 * hh; LAS char* tl = lds + DL_TLO + (32 * mb + r32) * 144 + 16 * hh;
        LAS char* vb = lds + DL_VBT + (32 * nb + r32) * 144 + 16 * hh; LAS char* kb = lds + DL_KBDT + (32 * nb + r32) * 144 + 16 * hh;
        f32x16 u, w;
#pragma unroll
        for (int r = 0; r < 16; ++r) { u[r] = 0.f; w[r] = 0.f; }
#pragma unroll
        for (int s = 0; s < 4; ++s) {
            const bf16x8 ah = *(const LAS bf16x8*)(th + 32 * s), al = *(const LAS bf16x8*)(tl + 32 * s), bv = *(const LAS bf16x8*)(vb + 32 * s), bk = *(const LAS bf16x8*)(kb + 32 * s);
            u = __builtin_amdgcn_mfma_f32_32x32x16_bf16(ah, bv, u, 0, 0, 0); u = __builtin_amdgcn_mfma_f32_32x32x16_bf16(al, bv, u, 0, 0, 0);
            w = __builtin_amdgcn_mfma_f32_32x32x16_bf16(bk, ah, w, 0, 0, 0); w = __builtin_amdgcn_mfma_f32_32x32x16_bf16(bk, al, w, 0, 0, 0);
        }
        unsigned pu[8];
#pragma unroll
        for (int e = 0; e < 8; ++e) pu[e] = pk2(u[2 * e], u[2 * e + 1]);
        bf16_t* U = (bf16_t*)(ib + DN_U) + ((mb * 4 + nb) * 64 + lane) * 16;
        *(u32x4*)U = (u32x4){pu[0], pu[1], pu[2], pu[3]}; *(u32x4*)(U + 8) = (u32x4){pu[4], pu[5], pu[6], pu[7]};
        bf16_t* W = (bf16_t*)(ib + DN_W) + (32 * mb + r32) * 128 + 32 * nb + 4 * hh;
#pragma unroll
        for (int g = 0; g < 4; ++g) { u32x2 o; o.x = pk2(-w[4 * g], -w[4 * g + 1]); o.y = pk2(-w[4 * g + 2], -w[4 * g + 3]); *(u32x2*)(W + 8 * g) = o; }
    }
    __syncthreads();
}

constexpr int SL_ST = 0, SL_VNT = 34816, SL_O = 53248, SL_WB = 87040, SL_QDB = 104448, SL_KDTB = 121856, SL_AQKB = 140288;
__device__ __forceinline__ void dn_scan(const Params& p, int l, int b, int h, LAS char* lds) {
    const int tid = otid(), lane = tid & 63, wid = tid >> 6, r32 = lane & 31, hh = lane >> 5;
    for (int i = tid; i < 34816 / 4; i += NTHREADS) ((LAS unsigned*)(lds + SL_ST))[i] = 0u;
    f32x16 S[2];
#pragma unroll
    for (int r = 0; r < 16; ++r) { S[0][r] = 0.f; S[1][r] = 0.f; }
    const int mb = wid >> 2, nb = wid & 3;
    const int vb = wid & 3, kb2 = wid >> 2;
    const bf16_t* PROJ = (const bf16_t*)(p.ws + WS_PROJ); bf16_t* MIX = (bf16_t*)(p.ws + WS_BF);
    const float* ng = inptr(p, I_DNG) + l * 128;
    const int ni = tid >> 3, npart = tid & 7;
    struct PfSet { u32x4 w[2], q[2], k[2], a, u[2]; float g; };
    PfSet s0, s1; u32x4 zn0, zn1;
    auto gload = [&](PfSet& r, int n) {
        const int item = (b * 4 + h) * 33 + n;
        const unsigned char* ib = p.ws + WS_X + (size_t)item * DN_ITEM_BYTES;
#pragma unroll
        for (int i = 0; i < 2; ++i) {
            const int pi = tid + 512 * i;
            r.w[i] = *(const u32x4*)(ib + DN_W + (pi >> 4) * 256 + (pi & 15) * 16);
            r.q[i] = *(const u32x4*)(ib + DN_QD + (pi >> 4) * 256 + (pi & 15) * 16);
            r.k[i] = *(const u32x4*)(ib + DN_KDT + (pi >> 3) * 128 + (pi & 7) * 16);
        }
        r.a = *(const u32x4*)(ib + DN_AQK + (tid >> 3) * 128 + (tid & 7) * 16);
        const bf16_t* U = (const bf16_t*)(ib + DN_U) + ((mb * 4 + nb) * 64 + lane) * 16;
        r.u[0] = *(const u32x4*)U; r.u[1] = *(const u32x4*)(U + 8);
        r.g = ((const float*)(p.ws + WS_GL))[item];
    };
    auto zload = [&](int n) {
        const int t = (n == 0) ? ni - 48 : NMETA + 64 * (n - 1) + ni;
        const bf16_t* zp = PROJ + (size_t)tok_row(b, t < 0 ? 0 : t) * 4096 + 1536 + h * 128 + 16 * npart;
        zn0 = *(const u32x4*)zp; zn1 = *(const u32x4*)(zp + 8);
    };
    auto lwrite = [&](const PfSet& r) {
#pragma unroll
        for (int i = 0; i < 2; ++i) {
            const int pi = tid + 512 * i;
            *(LAS u32x4*)(lds + SL_WB + (pi >> 4) * 272 + (pi & 15) * 16) = r.w[i];
            *(LAS u32x4*)(lds + SL_QDB + (pi >> 4) * 272 + (pi & 15) * 16) = r.q[i];
            *(LAS u32x4*)(lds + SL_KDTB + (pi >> 3) * 144 + (pi & 7) * 16) = r.k[i];
        }
        *(LAS u32x4*)(lds + SL_AQKB + (tid >> 3) * 144 + (tid & 7) * 16) = r.a;
    };
    gload(s0, 0); zload(0); lwrite(s0);
    u32x4 cU0 = s0.u[0], cU1 = s0.u[1], cZ0 = zn0, cZ1 = zn1; float cG = s0.g;
    __syncthreads();
    auto chunk = [&](int n, PfSet& fr, PfSet& nx) {
        const bool more = n + 1 < 33;
        if (more) { gload(nx, n + 1); zload(n + 1); }
        const float egl = __expf(cG);
        bf16x8 sf[8];
        {
            LAS char* sp = lds + SL_ST + (32 * nb + r32) * 272 + 16 * hh;
#pragma unroll
            for (int s = 0; s < 8; ++s) sf[s] = *(const LAS bf16x8*)(sp + 32 * s);
            f32x16 vn;
#pragma unroll
            for (int e = 0; e < 4; ++e) { vn[2 * e] = bf2f(cU0[e] & 0xffff); vn[2 * e + 1] = bf2f(cU0[e] >> 16); vn[8 + 2 * e] = bf2f(cU1[e] & 0xffff); vn[8 + 2 * e + 1] = bf2f(cU1[e] >> 16); }
            LAS char* wp = lds + SL_WB + (32 * mb + r32) * 272 + 16 * hh;
#pragma unroll
            for (int s = 0; s < 8; ++s) vn = __builtin_amdgcn_mfma_f32_32x32x16_bf16(*(const LAS bf16x8*)(wp + 32 * s), sf[s], vn, 0, 0, 0);
#pragma unroll
            for (int g = 0; g < 4; ++g) { u32x2 o; o.x = pk2(vn[4 * g], vn[4 * g + 1]); o.y = pk2(vn[4 * g + 2], vn[4 * g + 3]); *(LAS u32x2*)(lds + SL_VNT + (32 * nb + r32) * 144 + (32 * mb + 8 * g + 4 * hh) * 2) = o; }
        }
        __syncthreads();
        {
            f32x16 o;
#pragma unroll
            for (int r = 0; r < 16; ++r) o[r] = 0.f;
            LAS char* qp = lds + SL_QDB + (32 * mb + r32) * 272 + 16 * hh;
#pragma unroll
            for (int s = 0; s < 8; ++s) o = __builtin_amdgcn_mfma_f32_32x32x16_bf16(*(const LAS bf16x8*)(qp + 32 * s), sf[s], o, 0, 0, 0);
            LAS char* ap = lds + SL_AQKB + (32 * mb + r32) * 144 + 16 * hh;
            LAS char* vp = lds + SL_VNT + (32 * nb + r32) * 144 + 16 * hh;
#pragma unroll
            for (int s = 0; s < 4; ++s) o = __builtin_amdgcn_mfma_f32_32x32x16_bf16(*(const LAS bf16x8*)(ap + 32 * s), *(const LAS bf16x8*)(vp + 32 * s), o, 0, 0, 0);
#pragma unroll
            for (int r = 0; r < 16; ++r) *(LAS float*)(lds + SL_O + ((32 * mb + (r & 3) + 8 * (r >> 2) + 4 * hh) * 132 + 32 * nb + r32) * 4) = o[r];
            LAS char* vp4 = lds + SL_VNT + (32 * vb + r32) * 144 + 16 * hh;
            bf16x8 vf[4];
#pragma unroll
            for (int s = 0; s < 4; ++s) vf[s] = *(const LAS bf16x8*)(vp4 + 32 * s);
#pragma unroll
            for (int q = 0; q < 2; ++q) {
                LAS char* kp = lds + SL_KDTB + (32 * (2 * kb2 + q) + r32) * 144 + 16 * hh;
                S[q] = S[q] * egl;
#pragma unroll
                for (int s = 0; s < 4; ++s) S[q] = __builtin_amdgcn_mfma_f32_32x32x16_bf16(*(const LAS bf16x8*)(kp + 32 * s), vf[s], S[q], 0, 0, 0);
            }
        }
        __syncthreads();
#pragma unroll
        for (int q = 0; q < 2; ++q)
#pragma unroll
            for (int g = 0; g < 4; ++g) { u32x2 o; o.x = pk2(S[q][4 * g], S[q][4 * g + 1]); o.y = pk2(S[q][4 * g + 2], S[q][4 * g + 3]); *(LAS u32x2*)(lds + SL_ST + (32 * vb + r32) * 272 + (32 * (2 * kb2 + q) + 8 * g + 4 * hh) * 2) = o; }
        {
            const int t = (n == 0) ? ni - 48 : NMETA + 64 * (n - 1) + ni;
            float ov[16]; float ss = 0.f;
#pragma unroll
            for (int e4 = 0; e4 < 4; ++e4) { const f32x4 v4 = *(const LAS f32x4*)(lds + SL_O + (ni * 132 + 16 * npart + 4 * e4) * 4); ov[4 * e4] = v4.x; ov[4 * e4 + 1] = v4.y; ov[4 * e4 + 2] = v4.z; ov[4 * e4 + 3] = v4.w; ss += v4.x * v4.x + v4.y * v4.y + v4.z * v4.z + v4.w * v4.w; }
            ss = sum8_dpp(ss);
            if (t >= 0 && (n > 0 || b == 0)) {
                const float rms = rsqrtf(ss * (1.f / 128.f) + 1e-6f);
                unsigned po[8];
#pragma unroll
                for (int e = 0; e < 8; ++e) {
                    const unsigned zz = e < 4 ? cZ0[e] : cZ1[e - 4];
                    po[e] = pk2(ov[2 * e] * rms * bf2f(zz & 0xffff), ov[2 * e + 1] * rms * bf2f(zz >> 16));
                }
                bf16_t* mp = MIX + (size_t)tok_row(b, t) * D + h * 128 + 16 * npart;
                *(u32x4*)mp = (u32x4){po[0], po[1], po[2], po[3]}; *(u32x4*)(mp + 8) = (u32x4){po[4], po[5], po[6], po[7]};
            }
        }
        if (more) { lwrite(nx); cU0 = nx.u[0]; cU1 = nx.u[1]; cZ0 = zn0; cZ1 = zn1; cG = nx.g; }
        __syncthreads();
    };
    for (int n = 0; n < 33; ++n) chunk(n, s0, s0);
}

__device__ __forceinline__ int queue_pop(unsigned* ctr, LAS char* lds) {
    LAS int* slot = (LAS int*)(lds + LDS_BYTES - 16);
    __syncthreads();
    if (threadIdx.x == 0) *slot = (int)atomicAdd(ctr, 1u);
    __syncthreads();
    return *slot;
}


__device__ __forceinline__ int wave_sum_dpp(int v) {
    v += __builtin_amdgcn_mov_dpp(v, 0xB1, 0xf, 0xf, false);
    v += __builtin_amdgcn_mov_dpp(v, 0x4E, 0xf, 0xf, false);
    v += __builtin_amdgcn_mov_dpp(v, 0x141, 0xf, 0xf, false);
    v += __builtin_amdgcn_mov_dpp(v, 0x140, 0xf, 0xf, false);
    return __builtin_amdgcn_readlane(v, 0) + __builtin_amdgcn_readlane(v, 16) + __builtin_amdgcn_readlane(v, 32) + __builtin_amdgcn_readlane(v, 48);
}

__device__ __forceinline__ unsigned pk_gt1(unsigned keys, unsigned cm1, unsigned one2) {
    unsigned t, r;
    asm("v_pk_sub_u16 %0, %1, %2 clamp" : "=v"(t) : "v"(keys), "v"(cm1));
    asm("v_pk_min_u16 %0, %1, %2" : "=v"(r) : "v"(t), "v"(one2));
    return r;
}
__device__ __forceinline__ unsigned pk_add(unsigned a, unsigned b) { unsigned r; asm("v_pk_add_u16 %0, %1, %2" : "=v"(r) : "v"(a), "v"(b)); return r; }
__device__ __forceinline__ unsigned pk_count17(const unsigned (&pk)[17], unsigned cm1, unsigned one2) {
    unsigned t[17];
#pragma unroll
    for (int k = 0; k < 17; ++k) t[k] = pk_gt1(pk[k], cm1, one2);
#pragma unroll
    for (int k = 0; k < 8; ++k) t[k] = pk_add(t[k], t[k + 8]);
#pragma unroll
    for (int k = 0; k < 4; ++k) t[k] = pk_add(t[k], t[k + 4]);
    t[0] = pk_add(pk_add(t[0], t[1]), pk_add(t[2], t[3]));
    return pk_add(t[0], t[16]);
}
constexpr int CW_IDXF = 8192;
constexpr int IDX_SPLIT = 128;
constexpr int SC_PITCH = 2084;
__device__ __forceinline__ void idx_unit(const Params& p, int u, LAS char* lds) {
    const int tid = otid(), lane = tid & 63, wid = tid >> 6, r32 = lane & 31, hh = lane >> 5;
    const int b = u & 7, qb = 127 - (u >> 3);
    const int t0 = NMETA + 16 * qb, NK = t0 + 16, nkb = (NK + 31) >> 5;
    const bf16_t* PROJ = (const bf16_t*)(p.ws + WS_PROJ); const bf16_t* IK = (const bf16_t*)(p.ws + WS_IK); const float* PX = (const float*)(p.ws + WS_PX);
    unsigned* MASK = (unsigned*)(p.ws + WS_MASK);
    LAS float* SC = (LAS float*)lds;
    {
        const int qrow = b * SEQ + 16 * qb + (r32 & 15), hpar = r32 >> 4;
        bf16x8 qf[4][4]; float wq[4];
#pragma unroll
        for (int hp = 0; hp < 4; ++hp) {
#pragma unroll
            for (int s = 0; s < 4; ++s) qf[hp][s] = *(const bf16x8*)(PROJ + (size_t)qrow * 4096 + 3584 + (2 * hp + hpar) * 64 + 16 * s + 8 * hh);
            wq[hp] = PX[(size_t)qrow * 16 + 8 + 2 * hp + hpar] * (0.125f * 0.35355339059327373f);
        }
        bf16x8 kf[4], kn[4], kn2[4];
        auto kload = [&](bf16x8 (&dst)[4], int kb_) {
            int tk = 32 * kb_ + r32; tk = tk < LT ? tk : LT - 1;
            const bf16_t* kp = IK + (size_t)tok_row(b, tk) * 64 + 8 * hh;
#pragma unroll
            for (int s = 0; s < 4; ++s) dst[s] = *(const bf16x8*)(kp + 16 * s);
        };
        kload(kn, wid); kload(kn2, wid + 8);
        for (int kb = wid; kb < nkb; kb += 8) {
#pragma unroll
            for (int s = 0; s < 4; ++s) { kf[s] = kn[s]; kn[s] = kn2[s]; }
            kload(kn2, kb + 16);
            f32x16 sc;
#pragma unroll
            for (int r = 0; r < 16; ++r) sc[r] = 0.f;
#pragma unroll
            for (int hp = 0; hp < 4; ++hp) {
                f32x16 d;
#pragma unroll
                for (int r = 0; r < 16; ++r) d[r] = 0.f;
#pragma unroll
                for (int s = 0; s < 4; ++s) d = __builtin_amdgcn_mfma_f32_32x32x16_bf16(kf[s], qf[hp][s], d, 0, 0, 0);
#pragma unroll
                for (int r = 0; r < 16; ++r) sc[r] += wq[hp] * fmaxf(d[r], 0.f);
            }
#pragma unroll
            for (int r = 0; r < 16; ++r) sc[r] += __shfl_xor(sc[r], 16);
            if (hpar == 0) {
#pragma unroll
                for (int g = 0; g < 4; ++g) *(LAS f32x4*)(SC + (r32 & 15) * SC_PITCH + 32 * kb + 8 * g + 4 * hh) = (f32x4){sc[4 * g], sc[4 * g + 1], sc[4 * g + 2], sc[4 * g + 3]};
            }
        }
    }
    __syncthreads();
    {
        const int qa = 2 * wid, tqa = t0 + qa, tqb = tqa + 1;
        unsigned ua[33], ub[33];
#pragma unroll
        for (int j = 0; j < 33; ++j) {
            const int key = 64 * j + lane;
            float fa = (key <= tqa) ? SC[qa * SC_PITCH + key] : 0.f, fb = (key <= tqb) ? SC[(qa + 1) * SC_PITCH + key] : 0.f;
            fa += 0.f; fb += 0.f;
            const unsigned ba = __builtin_bit_cast(unsigned, fa), bb = __builtin_bit_cast(unsigned, fb);
            ua[j] = (key <= tqa) ? (ba ^ ((ba >> 31) ? 0xffffffffu : 0x80000000u)) : 0u;
            ub[j] = (key <= tqb) ? (bb ^ ((bb >> 31) ? 0xffffffffu : 0x80000000u)) : 0u;
        }
        unsigned one2 = 0x00010001u; asm volatile("" : "+v"(one2));
        unsigned pa[17], pb[17];
#pragma unroll
        for (int k = 0; k < 17; ++k) {
            pa[k] = (ua[2 * k] >> 16) | (k < 16 ? (ua[2 * k + 1] & 0xffff0000u) : 0u);
            pb[k] = (ub[2 * k] >> 16) | (k < 16 ? (ub[2 * k + 1] & 0xffff0000u) : 0u);
        }
        unsigned thra = 0u, thrb = 0u;
        bool acta = tqa + 1 > 256, actb = tqb + 1 > 256;
        bool p2a = acta, p2b = actb;
        for (int bit = 15; bit >= 0 && (acta || actb); --bit) {
            const unsigned ca = (thra | (1u << bit)) - 1u, cb = (thrb | (1u << bit)) - 1u;
            const unsigned ca2 = ca * 0x00010001u, cb2 = cb * 0x00010001u;
            const unsigned na = pk_count17(pa, ca2, one2), nb = pk_count17(pb, cb2, one2);
            const int ta = wave_sum_dpp((int)((na & 0xffffu) + (na >> 16))), tb = wave_sum_dpp((int)((nb & 0xffffu) + (nb >> 16)));
            if (acta) { if (ta >= 256) thra = ca + 1u; if (ta == 256) { acta = false; p2a = false; } }
            if (actb) { if (tb >= 256) thrb = cb + 1u; if (tb == 256) { actb = false; p2b = false; } }
        }
        int wanta = 0, wantb = 0;
        {
            const unsigned ha = thra * 0x00010001u, hb = thrb * 0x00010001u;
            const unsigned ga = pk_count17(pa, ha, one2), gb = pk_count17(pb, hb, one2);
            wanta = 256 - wave_sum_dpp((int)((ga & 0xffffu) + (ga >> 16))); wantb = 256 - wave_sum_dpp((int)((gb & 0xffffu) + (gb >> 16)));
#pragma unroll
            for (int k = 0; k < 17; ++k) {
                const unsigned a0 = ua[2 * k], a1 = k < 16 ? ua[2 * k + 1] : 0u, b0 = ub[2 * k], b1 = k < 16 ? ub[2 * k + 1] : 0u;
                pa[k] = ((a0 >> 16) == thra ? (a0 & 0xffffu) : 0u) | ((a1 >> 16) == thra ? (a1 << 16) : 0u);
                pb[k] = ((b0 >> 16) == thrb ? (b0 & 0xffffu) : 0u) | ((b1 >> 16) == thrb ? (b1 << 16) : 0u);
            }
        }
        unsigned lowa = 0u, lowb = 0u;
        acta = p2a; actb = p2b;
        for (int bit = 15; bit >= 0 && (acta || actb); --bit) {
            const unsigned ca = (lowa | (1u << bit)) - 1u, cb = (lowb | (1u << bit)) - 1u;
            const unsigned ca2 = ca * 0x00010001u, cb2 = cb * 0x00010001u;
            const unsigned na = pk_count17(pa, ca2, one2), nb = pk_count17(pb, cb2, one2);
            const int ta = wave_sum_dpp((int)((na & 0xffffu) + (na >> 16))), tb = wave_sum_dpp((int)((nb & 0xffffu) + (nb >> 16)));
            if (acta) { if (ta >= wanta) lowa = ca + 1u; if (ta == wanta) acta = false; }
            if (actb) { if (tb >= wantb) lowb = cb + 1u; if (tb == wantb) actb = false; }
        }
        thra = (thra << 16) | lowa; thrb = (thrb << 16) | lowb;
#pragma unroll
        for (int qq = 0; qq < 2; ++qq) {
            const int n = (qq ? tqb : tqa) + 1; const unsigned thr = qq ? thrb : thra;
            unsigned* mrow = MASK + (size_t)(b * SEQ + 16 * qb + qa + qq) * MASKW;
            int cg = 0;
#pragma unroll
            for (int j = 0; j < 33; ++j) cg += ((qq ? ub[j] : ua[j]) > thr) ? 1 : 0;
            const int need = 256 - wave_sum_dpp(cg);
            int ce = 0;
#pragma unroll
            for (int j = 0; j < 33; ++j) ce += ((qq ? ub[j] : ua[j]) == thr) ? 1 : 0;
            const bool simple = (n <= 256) || (wave_sum_dpp(ce) == need);
            int run = 0;
            unsigned wlo = 0u, whi = 0u;
            if (simple) {
                const unsigned tcmp = (n <= 256) ? 1u : thr;
#pragma unroll
                for (int j = 0; j < 33; ++j) {
                    const unsigned long long w = __ballot((qq ? ub[j] : ua[j]) >= tcmp);
                    if (lane == j) { wlo = (unsigned)w; whi = (unsigned)(w >> 32); }
                }
            } else {
#pragma unroll
                for (int j = 0; j < 33; ++j) {
                    const unsigned uv = qq ? ub[j] : ua[j];
                    const bool eq = uv == thr;
                    const unsigned long long beq = __ballot(eq);
                    const int rank = run + (int)__builtin_amdgcn_mbcnt_hi((unsigned)(beq >> 32), __builtin_amdgcn_mbcnt_lo((unsigned)beq, 0u));
                    const bool take = (uv > thr) || (eq && rank < need);
                    const unsigned long long w = __ballot(take);
                    run += __popcll(beq);
                    if (lane == j) { wlo = (unsigned)w; whi = (unsigned)(w >> 32); }
                }
            }
            if (lane < 34) __hip_atomic_store((unsigned long long*)(mrow + 2 * lane), ((unsigned long long)whi << 32) | wlo, __ATOMIC_RELAXED, __HIP_MEMORY_SCOPE_AGENT);
        }
    }
}
__device__ __forceinline__ void meta_mask_unit(const Params& p) {
    unsigned* MASK = (unsigned*)(p.ws + WS_MASK) + (size_t)NMAIN * MASKW;
    for (int i = otid(); i < NMETA * MASKW; i += NTHREADS) { const int t = i / MASKW, w = i % MASKW; MASK[i] = w == 0 ? ((2u << t) - 1u) : 0u; }
}

constexpr int AL_VT = 9216, AL_STG = 21504;
__device__ __forceinline__ void attn_unit(const Params& p, int l_, int item, LAS char* lds) {
    const int tid = otid(), lane = tid & 63, wid = tid >> 6, r32 = lane & 31, hh = lane >> 5;
    const bool meta = item >= 512;
    const int qblk = meta ? 0 : 7 - (item >> 6), b = meta ? 0 : (item & 63) >> 3, h = meta ? item - 512 : item & 7;
    if (!meta && (127 - 16 * qblk) * 8 + b >= IDX_SPLIT) {
        if (tid == 0) {
            unsigned* f = (unsigned*)(p.ws + WS_CTL) + CW_IDXF + l_ * 64 + b * 8 + qblk;
            unsigned sp = 0u;
            while (__hip_atomic_load(f, __ATOMIC_RELAXED, __HIP_MEMORY_SCOPE_AGENT) < 16u && ++sp < (1u << 22)) __builtin_amdgcn_s_sleep(2);
            __builtin_amdgcn_fence(__ATOMIC_ACQUIRE, "agent");
            asm volatile("s_waitcnt vmcnt(0)" ::: "memory");
        }
        __syncthreads();
    }
    const int qi = 32 * wid + r32;
    const bool qvalid = !meta || qi < NMETA;
    const int qrow = meta ? NMAIN + (qvalid ? qi : NMETA - 1) : b * SEQ + 256 * qblk + qi;
    const int ntiles = meta ? 1 : 4 * qblk + 5;
    const int wt_last = meta ? 0 : (NMETA + 256 * qblk + 32 * wid + 31) >> 6;
    const bf16_t* PROJ = (const bf16_t*)(p.ws + WS_PROJ);
    const unsigned* mrow = (const unsigned*)(p.ws + WS_MASK) + (size_t)qrow * MASKW;
    bf16x8 qf[4];
#pragma unroll
    for (int s = 0; s < 4; ++s) qf[s] = *(const bf16x8*)(PROJ + (size_t)qrow * 4096 + 2048 + h * 64 + 16 * s + 8 * hh);
    float m = -1e30f, l = 0.f; f32x16 o[2];
#pragma unroll
    for (int r = 0; r < 16; ++r) { o[0][r] = 0.f; o[1][r] = 0.f; }
    const int skey = tid >> 3, sch = tid & 7;
    u32x4 kreg, vreg;
    auto gload = [&](int j) {
        int tk = 64 * j + skey; tk = tk < LT ? tk : LT - 1;
        const bf16_t* rp = PROJ + (size_t)tok_row(b, tk) * 4096 + h * 64 + 8 * sch;
        kreg = *(const u32x4*)(rp + 2560); vreg = *(const u32x4*)(rp + 3072);
    };
    auto lwrite = [&](int st) {
        LAS char* sb = lds + st * AL_STG;
        *(LAS u32x4*)(sb + skey * 144 + sch * 16) = kreg;
        *(LAS u32x4*)(sb + AL_VT + skey * 192 + sch * 16) = vreg;
    };
    gload(0); lwrite(0);
    u32x2 mwn = *(const u32x2*)(mrow);
    __syncthreads();
    for (int j = 0; j < ntiles; ++j) {
        const bool more = j + 1 < ntiles;
        if (more) gload(j + 1);
        const u32x2 mw = mwn;
        if (more) mwn = *(const u32x2*)(mrow + 2 * (j + 1));
        if (j <= wt_last) {
            const unsigned mw0 = qvalid ? mw.x : 0u, mw1 = qvalid ? mw.y : 0u;
            LAS char* sb = lds + (j & 1) * AL_STG;
            f32x16 p0, p1;
#pragma unroll
            for (int r = 0; r < 16; ++r) { p0[r] = 0.f; p1[r] = 0.f; }
#pragma unroll
            for (int s = 0; s < 4; ++s) {
                const bf16x8 k0 = *(const LAS bf16x8*)(sb + r32 * 144 + 32 * s + 16 * hh), k1 = *(const LAS bf16x8*)(sb + (32 + r32) * 144 + 32 * s + 16 * hh);
                p0 = __builtin_amdgcn_mfma_f32_32x32x16_bf16(k0, qf[s], p0, 0, 0, 0); p1 = __builtin_amdgcn_mfma_f32_32x32x16_bf16(k1, qf[s], p1, 0, 0, 0);
            }
            float tmax = -INFINITY;
#pragma unroll
            for (int r = 0; r < 16; ++r) {
                const int bit = (r & 3) + 8 * (r >> 2) + 4 * hh;
                p0[r] = ((mw0 >> bit) & 1u) ? p0[r] : -INFINITY; p1[r] = ((mw1 >> bit) & 1u) ? p1[r] : -INFINITY;
                tmax = fmaxf(tmax, fmaxf(p0[r], p1[r]));
            }
            { const unsigned tb_ = __builtin_bit_cast(unsigned, tmax); auto rr = __builtin_amdgcn_permlane32_swap(tb_, tb_, false, false); tmax = fmaxf(__builtin_bit_cast(float, (unsigned)rr[0]), __builtin_bit_cast(float, (unsigned)rr[1])); }
            const float mnew = fmaxf(m, tmax), alpha = __builtin_amdgcn_exp2f(m - mnew);
            float rs = 0.f;
#pragma unroll
            for (int r = 0; r < 16; ++r) { p0[r] = __builtin_amdgcn_exp2f(p0[r] - mnew); p1[r] = __builtin_amdgcn_exp2f(p1[r] - mnew); rs += p0[r] + p1[r]; }
            { const unsigned rb_ = __builtin_bit_cast(unsigned, rs); auto rr = __builtin_amdgcn_permlane32_swap(rb_, rb_, false, false); rs = __builtin_bit_cast(float, (unsigned)rr[0]) + __builtin_bit_cast(float, (unsigned)rr[1]); }
            l = l * alpha + rs; m = mnew;
            o[0] = o[0] * alpha; o[1] = o[1] * alpha;
#pragma unroll
            for (int blk = 0; blk < 2; ++blk)
#pragma unroll
                for (int s = 0; s < 2; ++s) {
                    u32x4 pw;
#pragma unroll
                    for (int e = 0; e < 4; ++e) pw[e] = blk ? pk2(p1[8 * s + 2 * e], p1[8 * s + 2 * e + 1]) : pk2(p0[8 * s + 2 * e], p0[8 * s + 2 * e + 1]);
                    const bf16x8 pf = __builtin_bit_cast(bf16x8, pw);
#pragma unroll
                    for (int db = 0; db < 2; ++db) {
                        LAS char* vp = sb + AL_VT + (32 * blk + 16 * s + 4 * hh + ((lane & 15) >> 2)) * 192 + (32 * db + (lane & 16) + 4 * (lane & 3)) * 2;
                        typedef short v4i16_t __attribute__((ext_vector_type(4)));
                        const v4i16_t va = __builtin_amdgcn_ds_read_tr16_b64_v4i16((LAS v4i16_t*)vp), vb = __builtin_amdgcn_ds_read_tr16_b64_v4i16((LAS v4i16_t*)(vp + 8 * 192));
                        const bf16x8 vf = (bf16x8){va[0], va[1], va[2], va[3], vb[0], vb[1], vb[2], vb[3]};
                        o[db] = __builtin_amdgcn_mfma_f32_32x32x16_bf16(vf, pf, o[db], 0, 0, 0);
                    }
                }
        }
        if (more) lwrite((j + 1) & 1);
        __syncthreads();
    }
    if (qvalid) {
        const float inv = 1.f / l;
        bf16_t* dst = (bf16_t*)(p.ws + WS_BF) + (size_t)qrow * D + 512 + h * 64 + 4 * hh;
#pragma unroll
        for (int db = 0; db < 2; ++db)
#pragma unroll
            for (int g = 0; g < 4; ++g) { u32x2 ov; ov.x = pk2(o[db][4 * g] * inv, o[db][4 * g + 1] * inv); ov.y = pk2(o[db][4 * g + 2] * inv, o[db][4 * g + 3] * inv); *(u32x2*)(dst + 32 * db + 8 * g) = ov; }
    }
}

__device__ __forceinline__ void phaseB(const Params& p, int l, bool second, int ph, LAS char* lds) {
    unsigned* ctr = (unsigned*)(p.ws + WS_CTL) + 16 + ph;
    if (second) { if (blockIdx.x < 32) dn_scan(p, l, blockIdx.x >> 2, blockIdx.x & 3, lds); }
    else if (blockIdx.x == gridDim.x - 1) meta_mask_unit(p);
    const int u0 = second ? IDX_SPLIT : 0, n_idx = second ? 1024 - IDX_SPLIT : IDX_SPLIT, n_tot = n_idx + (second ? 520 : 1056);
    for (;;) {
        const int it = queue_pop(ctr, lds);
        if (it >= n_tot) break;
        if (it < n_idx) {
            const int u = it + u0;
            idx_unit(p, u, lds);
            asm volatile("s_waitcnt vmcnt(0)" ::: "memory");
            __syncthreads();
            if (threadIdx.x == 0) __hip_atomic_fetch_add((unsigned*)(p.ws + WS_CTL) + CW_IDXF + l * 64 + (u & 7) * 8 + ((127 - (u >> 3)) >> 4), 1u, __ATOMIC_RELAXED, __HIP_MEMORY_SCOPE_AGENT);
        } else if (second) attn_unit(p, l, it - n_idx, lds);
        else dn_intra_item(p, l, it - n_idx, lds);
    }
}

constexpr int CW_CNT = 256;

__device__ __forceinline__ void phaseD(const Params& p, int l, int nrows, LAS char* lds) {
    const int tid = otid(), lane = tid & 63, wid = tid >> 6;
    const int gw = blockIdx.x * 8 + wid, NGW = gridDim.x * 8;
    {
        LAS char* scr = lds + wid * 9216;
        const float* w1 = inptr(p, I_W1) + (size_t)l * NEXP * D * DEXP; const float* w3 = inptr(p, I_W3) + (size_t)l * NEXP * D * DEXP; const float* w2 = inptr(p, I_W2) + (size_t)l * NEXP * DEXP * D;
        for (int it = gw; it < NEXP * 192; it += NGW) {
            const int e = it / 192; int r = it % 192;
            if (r < 128) {
                const int isb = r >> 6, kb = (r >> 2) & 15, nb = r & 3;
                auto orow = [&](int f) -> int { return 64 * (f >> 5) + 32 * isb + (f & 31); };
                transpose_tile64((isb ? w3 : w1) + (size_t)e * D * DEXP, DEXP, kb * 64, nb * 64, (bf16_t*)(p.ws + WS_W13T) + (size_t)e * 512 * D, D, orow, scr, lane);
            } else {
                r -= 128; const int kb = r >> 4, nb = r & 15;
                auto orow = [&](int n) -> int { return n; };
                transpose_tile64(w2 + (size_t)e * DEXP * D, D, kb * 64, nb * 64, (bf16_t*)(p.ws + WS_W2T) + (size_t)e * D * DEXP, DEXP, orow, scr, lane);
            }
        }
    }
    __syncthreads();
    LAS float* Wl = (LAS float*)lds;
    LAS unsigned* lcnt = (LAS unsigned*)(lds + 147456);
    LAS unsigned* lbase = lcnt + 32;
    LAS unsigned* lent = lcnt + 64;
    {
        const f32x4* rw = (const f32x4*)(p.ws + WS_RW + (size_t)l * D * 36 * 4);
        for (int idx = tid; idx < D * 9; idx += NTHREADS) *(LAS f32x4*)(lds + idx * 16) = rw[idx];
        if (tid < 32) lcnt[tid] = 0u;
        for (int idx = tid; idx < 8 * 10 * 2; idx += NTHREADS) lent[idx * 4] = 0xffffffffu;
    }
    __syncthreads();
    const float* g = inptr(p, I_LN1G) + l * D; const float* bb = inptr(p, I_LN1B) + l * D;
    const float* bg = inptr(p, I_BGRP) + l * 4; const float* br = inptr(p, I_BRTR) + l * 32;
    bf16_t* Hb = (bf16_t*)(p.ws + WS_BF);
    unsigned* cnt = (unsigned*)(p.ws + WS_CTL) + CW_CNT + l * 64;
    unsigned* list = (unsigned*)(p.ws + WS_LIST); float* listg = (float*)(p.ws + WS_LISTG);
    int kr = 0;
    u32x2 vnx[4];
    if (gw < nrows) {
#pragma unroll
        for (int j = 0; j < 4; ++j) vnx[j] = *(const u32x2*)(y1_row(p, gw) + (lane + 64 * j) * 4);
    }
    for (int row = gw; row < nrows; row += NGW, ++kr) {
        f32x4 v[4]; float s = 0.f;
#pragma unroll
        for (int j = 0; j < 4; ++j) { v[j] = bf4(vnx[j]); s += (v[j].x + v[j].y) + (v[j].z + v[j].w); }
        if (row + NGW < nrows) {
            const bf16_t* np_ = y1_row(p, row + NGW);
#pragma unroll
            for (int j = 0; j < 4; ++j) vnx[j] = *(const u32x2*)(np_ + (lane + 64 * j) * 4);
        }
        const float mean = wave_sum(s) * (1.f / D); float s2 = 0.f;
#pragma unroll
        for (int j = 0; j < 4; ++j) { v[j] = v[j] - mean; s2 += (v[j].x * v[j].x + v[j].y * v[j].y) + (v[j].z * v[j].z + v[j].w * v[j].w); }
        const float rstd = 1.f / sqrtf(wave_sum(s2) * (1.f / D) + 1e-5f);
        f32x4 lg = (f32x4){0.f, 0.f, 0.f, 0.f};
#pragma unroll
        for (int j = 0; j < 4; ++j) {
            const f32x4 gg = *(const f32x4*)(g + (lane + 64 * j) * 4), bv = *(const f32x4*)(bb + (lane + 64 * j) * 4);
            const f32x4 o = v[j] * rstd * gg + bv; v[j] = o;
            u32x2 ob; ob.x = pk2(o.x, o.y); ob.y = pk2(o.z, o.w);
            *(u32x2*)(Hb + (size_t)row * D + (lane + 64 * j) * 4) = ob;
#pragma unroll
            for (int i = 0; i < 4; ++i) lg += *(const LAS f32x4*)(Wl + ((j * 4 + i) * 64 + lane) * 36) * o[i];
        }
        float l0 = wave_sum(lg.x) + bg[0], l1 = wave_sum(lg.y) + bg[1], l2 = wave_sum(lg.z) + bg[2], l3 = wave_sum(lg.w) + bg[3];
        int gsel = 0; float gm = l0;
        if (l1 > gm) { gm = l1; gsel = 1; }
        if (l2 > gm) { gm = l2; gsel = 2; }
        if (l3 > gm) { gm = l3; gsel = 3; }
        const float gprob = 1.f / (__expf(l0 - gm) + __expf(l1 - gm) + __expf(l2 - gm) + __expf(l3 - gm));
        gsel = __builtin_amdgcn_readfirstlane(gsel);
        f32x4 ea = (f32x4){0.f, 0.f, 0.f, 0.f}, eb = (f32x4){0.f, 0.f, 0.f, 0.f};
#pragma unroll
        for (int j = 0; j < 4; ++j)
#pragma unroll
            for (int i = 0; i < 4; ++i) {
                const LAS float* wp = Wl + ((j * 4 + i) * 64 + lane) * 36 + 4 + 8 * gsel;
                ea += *(const LAS f32x4*)(wp) * v[j][i]; eb += *(const LAS f32x4*)(wp + 4) * v[j][i];
            }
        float el[8];
        el[0] = wave_sum(ea.x); el[1] = wave_sum(ea.y); el[2] = wave_sum(ea.z); el[3] = wave_sum(ea.w);
        el[4] = wave_sum(eb.x); el[5] = wave_sum(eb.y); el[6] = wave_sum(eb.z); el[7] = wave_sum(eb.w);
#pragma unroll
        for (int i = 0; i < 8; ++i) el[i] += br[8 * gsel + i];
        int i0 = 0; float m0 = el[0];
#pragma unroll
        for (int i = 1; i < 8; ++i) if (el[i] > m0) { m0 = el[i]; i0 = i; }
        int i1 = -1; float m1 = -INFINITY;
#pragma unroll
        for (int i = 0; i < 8; ++i) if (i != i0 && el[i] > m1) { m1 = el[i]; i1 = i; }
        const float x1 = __expf(m1 - m0);
        const float gate0 = gprob / (1.f + x1), gate1 = gprob * x1 / (1.f + x1);
        if (lane == 0) {
            const int e0 = gsel * 8 + i0, e1 = gsel * 8 + i1;
            const unsigned r0 = __hip_atomic_fetch_add(lcnt + e0, 1u, __ATOMIC_RELAXED, __HIP_MEMORY_SCOPE_WORKGROUP), r1 = __hip_atomic_fetch_add(lcnt + e1, 1u, __ATOMIC_RELAXED, __HIP_MEMORY_SCOPE_WORKGROUP);
            LAS unsigned* en = lent + ((wid * 10 + kr) * 2) * 4;
            en[0] = (unsigned)e0; en[1] = r0; en[2] = (unsigned)row * 2u; en[3] = __builtin_bit_cast(unsigned, gate0);
            en[4] = (unsigned)e1; en[5] = r1; en[6] = (unsigned)row * 2u + 1u; en[7] = __builtin_bit_cast(unsigned, gate1);
        }
    }
    __syncthreads();
    if (tid < 32) { const unsigned c = lcnt[tid]; lbase[tid] = c ? atomicAdd(cnt + tid, c) : 0u; }
    __syncthreads();
    if (tid < 8 * 10 * 2) {
        const unsigned e = lent[tid * 4];
        if (e != 0xffffffffu) { const unsigned pos = lbase[e] + lent[tid * 4 + 1]; list[e * LIST_CAP + pos] = lent[tid * 4 + 2]; listg[e * LIST_CAP + pos] = __builtin_bit_cast(float, lent[tid * 4 + 3]); }
    }
}

constexpr int MOE_TAB = 131072;
__device__ __forceinline__ void moe_build_table(const unsigned* cnt, LAS int* tab) {
    const int tid = otid();
    __syncthreads();
    if (tid < 32) tab[tid] = (int)cnt[tid];
    __syncthreads();
    if (tid == 0) { int acc = 0; for (int e = 0; e < NEXP; ++e) { tab[32 + e] = acc; acc += (tab[e] + 255) >> 8; } tab[64] = acc; }
    __syncthreads();
}
template <int NT>
__device__ __forceinline__ bool moe_unit(const LAS int* tab, int u, int& e, int& mt, int& nt, int& c, int& hb) {
    const int gt = u / NT; nt = u % NT;
    if (gt >= tab[64]) return false;
    int lo = 0;
#pragma unroll
    for (int s = 16; s > 0; s >>= 1) if (tab[32 + lo + s] <= gt) lo += s;
    e = lo; mt = gt - tab[32 + e]; c = tab[e]; hb = tab[32 + e] * 256;
    return true;
}
__device__ __forceinline__ void phaseE1(const Params& p, int l, LAS char* lds) {
    const int hh = (otid() & 63) >> 5;
    const unsigned* cnt = (const unsigned*)(p.ws + WS_CTL) + CW_CNT + l * 64;
    const unsigned* list = (const unsigned*)(p.ws + WS_LIST); const float* listg = (const float*)(p.ws + WS_LISTG);
    const bf16_t* H1b = (const bf16_t*)(p.ws + WS_BF); bf16_t* HID = (bf16_t*)(p.ws + WS_HID);
    LAS int* tab = (LAS int*)(lds + MOE_TAB);
    moe_build_table(cnt, tab);
    for (int u = blockIdx.x;; u += gridDim.x) {
        int e, mt, nt, c, hb;
        if (!moe_unit<4>(tab, u, e, mt, nt, c, hb)) break;
        auto arow = [&](int r) -> const bf16_t* { const int idx = mt * 256 + r; const unsigned ent = list[e * LIST_CAP + (idx < c ? idx : 0)]; return H1b + (size_t)(ent >> 1) * D; };
        auto epi = [&](int mloc, int nloc0, const f32x16& c0, const f32x16& c1) {
            const int idx = mt * 256 + mloc;
            if (idx < c) {
                const float gt = listg[e * LIST_CAP + idx];
                bf16_t* dst = HID + (size_t)(hb + idx) * DEXP + (nt * 2 + (nloc0 >> 6)) * 32 + 4 * hh;
#pragma unroll
                for (int g = 0; g < 4; ++g) {
                    float h[4];
#pragma unroll
                    for (int j = 0; j < 4; ++j) { const float a = c0[4 * g + j], b = c1[4 * g + j]; h[j] = silu_f(a) * b * gt; }
                    u32x2 o; o.x = pk2(h[0], h[1]); o.y = pk2(h[2], h[3]);
                    *(u32x2*)(dst + 8 * g) = o;
                }
            }
        };
        gemm_tile<2>(lds, arow, (const bf16_t*)(p.ws + WS_W13T) + ((size_t)e * 512 + nt * 128) * D, D, epi);
    }
}

#define XB_TMO      128
#define XB_XCNT(j)  (256  + 64 * (j))
#define XB_XSUB(j)  (1280 + 64 * (j))
#define XB_XGEN(j)  (2304 + 64 * (j))
#define XB_TOP      3328
#define XB_TOPGEN   3392
#define XCD_BAR_WORDS 3456
#define XB_SPIN_CAP (1u << 18)
constexpr int CW_BAR = 4096;
__device__ __forceinline__ unsigned xb_ld(unsigned* p)              { return __hip_atomic_load(p, __ATOMIC_RELAXED, __HIP_MEMORY_SCOPE_AGENT); }
__device__ __forceinline__ unsigned xb_add(unsigned* p, unsigned v) { return __hip_atomic_fetch_add(p, v, __ATOMIC_RELAXED, __HIP_MEMORY_SCOPE_AGENT); }
__device__ __forceinline__ unsigned xb_xcc_id() { return (unsigned)__builtin_amdgcn_s_getreg((3 << 11) | 20) & 0xFu; }
#define XB_SPIN(cond, bar) do { unsigned _sp = 0; while (cond) { __builtin_amdgcn_s_sleep(1); \
    if ((++_sp & 255u) == 0u) { if (xb_ld(&(bar)[XB_TMO])) break; if (_sp > XB_SPIN_CAP) { atomicAdd(&(bar)[XB_TMO], 1u); break; } } } } while (0)
struct XcdBarrier { unsigned* bar; unsigned x; volatile LAS unsigned* st; };
__device__ __forceinline__ XcdBarrier xcd_barrier_post(unsigned* bar, volatile LAS unsigned* st) {
    XcdBarrier b; b.bar = bar; b.x = xb_xcc_id(); b.st = st;
    if (threadIdx.x == 0) (void)xb_add(&bar[XB_XCNT(b.x)], 1u);
    return b;
}
__device__ __forceinline__ void xcd_barrier_complete(unsigned* bar, unsigned x, unsigned& nloc, unsigned& nx) {
    const unsigned G = gridDim.x * gridDim.y * gridDim.z;
    unsigned sum, cnt, mine, sp = 0u;
    for (;;) {
        sum = 0u; cnt = 0u; mine = 0u;
#pragma unroll
        for (unsigned j = 0; j < 16; ++j) { const unsigned c = xb_ld(&bar[XB_XCNT(j)]); sum += c; cnt += (c > 0u) ? 1u : 0u; mine = (j == x) ? c : mine; }
        if (sum == G) break;
        __builtin_amdgcn_s_sleep(1);
        if ((++sp & 255u) == 0u) { if (xb_ld(&bar[XB_TMO])) break; if (sp > XB_SPIN_CAP) { atomicAdd(&bar[XB_TMO], 1u); break; } }
    }
    nloc = mine > 0u ? mine : 1u; nx = cnt > 0u ? cnt : 1u;
}
__device__ __forceinline__ void xcd_barrier(const XcdBarrier& b) {
    asm volatile("s_waitcnt vmcnt(0)" ::: "memory");
    __syncthreads();
    if (threadIdx.x == 0) {
        unsigned* bar = b.bar;
        __builtin_amdgcn_s_waitcnt(0);
        unsigned nloc = b.st[0], nx = b.st[1];
        if (nloc == 0u) { xcd_barrier_complete(bar, b.x, nloc, nx); b.st[0] = nloc; b.st[1] = nx; }
        const unsigned old = xb_add(&bar[XB_XSUB(b.x)], 1u);
        const unsigned gen = old / nloc;
        if (old + 1u == (gen + 1u) * nloc) {
            __builtin_amdgcn_fence(__ATOMIC_RELEASE, "agent");
            asm volatile("s_waitcnt vmcnt(0)" ::: "memory");
            const unsigned og = xb_add(&bar[XB_TOP], 1u);
            const unsigned tg = og / nx;
            if (og + 1u == (tg + 1u) * nx) xb_add(&bar[XB_TOPGEN], 1u);
            else XB_SPIN(xb_ld(&bar[XB_TOPGEN]) == tg, bar);
            __builtin_amdgcn_fence(__ATOMIC_ACQUIRE, "agent");
            xb_add(&bar[XB_XGEN(b.x)], 1u);
            asm volatile("s_waitcnt vmcnt(0)" ::: "memory");
        } else {
            XB_SPIN(xb_ld(&bar[XB_XGEN(b.x)]) == gen, bar);
            __builtin_amdgcn_fence(__ATOMIC_ACQUIRE, "agent");
            asm volatile("s_waitcnt vmcnt(0)" ::: "memory");
        }
    }
    __syncthreads();
}

constexpr int NPHASE = 17;
__global__ void __launch_bounds__(NTHREADS, 2) mega(Params p) {
    extern __shared__ __attribute__((aligned(16))) unsigned char lds_raw[];
    LAS char* lds = (LAS char*)lds_raw;
    cg::grid_group grid = cg::this_grid();
    volatile LAS unsigned* bst = (volatile LAS unsigned*)(lds + LDS_BYTES - 32);
    if (threadIdx.x < 2) bst[threadIdx.x] = 0u;
    __syncthreads();
    const XcdBarrier xbar = xcd_barrier_post((unsigned*)(p.ws + WS_CTL) + CW_BAR, bst);
    for (int ph = p.ph_lo; ph < p.ph_hi; ++ph) {
        { unsigned la = (unsigned)(uintptr_t)lds; asm volatile("" : "+v"(la)); lds = (LAS char*)(uintptr_t)la; }
        if (ph == 0) phase0(p, lds);
        else {
            const int l = (ph - 1) >> 3, s = (ph - 1) & 7;
            const int nrows = (l == 1) ? NMAIN : NROWS;
            if (s == 0) phaseA(p, l, lds);
            else if (s == 1 || s == 2) phaseB(p, l, s == 2, ph, lds);
            else if (s == 3 || s == 6) phaseCE(p, l, lds, s == 6 ? 1 : 0);
            else if (s == 4) phaseD(p, l, nrows, lds);
            else if (s == 5) phaseE1(p, l, lds);
            else if (s == 7) phaseG(p, l, nrows, l == 1);
        }
        if (ph + 1 < p.ph_hi) { if (ph == 0) grid.sync(); else xcd_barrier(xbar); }
    }
}

extern "C" void kernel_launch(void* const* d_in, const int* in_sizes, int n_in, void* d_out, int out_size, void* d_ws, size_t ws_size, hipStream_t stream) {
    static int grid = 0;
    if (grid == 0) {
        if (n_in != 19 || out_size != NMAIN * D || ws_size < WS_END) { fprintf(stderr, "kernel_launch: unexpected shapes (n_in %d out %d ws %zu)\n", n_in, out_size, ws_size); grid = -1; return; }
        int dev = 0, cus = 0, per_cu = 0;
        hipGetDevice(&dev);
        hipDeviceGetAttribute(&cus, hipDeviceAttributeMultiprocessorCount, dev);
        hipFuncSetAttribute((const void*)mega, hipFuncAttributeMaxDynamicSharedMemorySize, LDS_BYTES);
        hipOccupancyMaxActiveBlocksPerMultiprocessor(&per_cu, (const void*)mega, NTHREADS, LDS_BYTES);
        if (per_cu < 1) { fprintf(stderr, "kernel_launch: occupancy query says %d\n", per_cu); per_cu = 1; }
        (void)hipGetLastError();
        grid = cus;
    }
    if (grid < 0) return;
    hipMemsetAsync((char*)d_ws + WS_CTL, 0, CTL_BYTES, stream);
    Params p{};
    for (int i = 0; i < 19; ++i) p.in[i] = (const float*)d_in[i];
    p.out = (float*)d_out; p.ws = (unsigned char*)d_ws;
    for (int i = 0; i < 32; ++i) p.rope_inv[i] = (float)(1.0 / pow(10000.0, (double)(2 * i) / 64.0));
    p.ph_lo = 0; p.ph_hi = NPHASE;
    void* args[] = {&p};
    hipError_t e = hipLaunchCooperativeKernel((const void*)mega, dim3(grid), dim3(NTHREADS), args, LDS_BYTES, stream);
    if (e != hipSuccess) fprintf(stderr, "cooperative launch failed: %s (grid %d)\n", hipGetErrorString(e), grid);
}
```

```cpp
#include <hip/hip_runtime.h>
#include <hip/hip_cooperative_groups.h>
#include <cstdio>
#include <cstdint>
#include <cmath>
namespace cg = cooperative_groups;

#define LAS __attribute__((address_space(3)))
typedef unsigned short bf16_t;
typedef short bf16x8 __attribute__((ext_vector_type(8)));
typedef float f32x16 __attribute__((ext_vector_type(16)));
typedef float f32x4 __attribute__((ext_vector_type(4)));
typedef unsigned u32x4 __attribute__((ext_vector_type(4)));
typedef unsigned u32x2 __attribute__((ext_vector_type(2)));

constexpr int D = 1024, NB = 8, SEQ = 2048, NMETA = 16, LT = SEQ + NMETA;
constexpr int NMAIN = NB * SEQ;
constexpr int NROWS = NMAIN + NMETA;
constexpr int MROWS = NMAIN + 256;
constexpr int NPROJP = 4352;
constexpr int NEXP = 32, DEXP = 256;
constexpr float ALPHA = 1.4142135623730951f;
constexpr int NTHREADS = 512;
constexpr int LDS_BYTES = 155648;

constexpr size_t MiB = 1u << 20;
constexpr size_t WS_CTL = 0;
constexpr size_t CTL_BYTES = 65536;
constexpr size_t WS_ROPE = 1 * MiB;
constexpr size_t WS_METAR = 2 * MiB;
constexpr size_t WS_PX = 3 * MiB;
constexpr size_t WS_IK = 5 * MiB;
constexpr size_t WS_MASK = 8 * MiB;
constexpr size_t WS_LIST = 13 * MiB;
constexpr size_t WS_LISTG = 16 * MiB;
constexpr size_t WS_GL = 19 * MiB;
constexpr size_t WS_RW = 19 * MiB + 65536;
constexpr size_t WS_WIN = 20 * MiB;
constexpr size_t WS_WOUT = 37 * MiB;
constexpr size_t WS_BF = 42 * MiB;
constexpr size_t WS_PROJ = 75 * MiB;
constexpr size_t WS_EO = WS_PROJ;
constexpr size_t WS_HID = WS_PROJ + 66 * MiB;
constexpr size_t WS_X = 205 * MiB;
constexpr size_t WS_END = 280 * MiB;
constexpr int MASKW = 68;
constexpr int LIST_CAP = 16400;
constexpr size_t WS_W13T = WS_X;
constexpr size_t WS_W2T = WS_X + 32 * MiB;

struct Params {
    const float* in[19];
    float* out;
    unsigned char* ws;
    float rope_inv[32];
    int ph_lo, ph_hi;
};
enum { I_X = 0, I_META, I_WIN, I_CONV, I_ALOG, I_DTB, I_DNG, I_WOUT, I_LN1G, I_LN1B, I_WGRP, I_BGRP, I_WRTR, I_BRTR, I_W1, I_W3, I_W2, I_LN2G, I_LN2B };

typedef float f32x2_t __attribute__((ext_vector_type(2))); typedef __bf16 bf16x2_t __attribute__((ext_vector_type(2)));
__device__ __forceinline__ unsigned pk2(float lo, float hi) { const f32x2_t v = {lo, hi}; const bf16x2_t b = __builtin_convertvector(v, bf16x2_t); return __builtin_bit_cast(unsigned, b); }
__device__ __forceinline__ unsigned f2bf(float f) { return pk2(f, 0.f) & 0xffffu; }
__device__ __forceinline__ float bf2f(unsigned short b) { return __builtin_bit_cast(float, (unsigned)b << 16); }

__device__ __forceinline__ float sum8_dpp(float v) {
    v += __builtin_bit_cast(float, __builtin_amdgcn_mov_dpp(__builtin_bit_cast(int, v), 0xB1, 0xf, 0xf, false));
    v += __builtin_bit_cast(float, __builtin_amdgcn_mov_dpp(__builtin_bit_cast(int, v), 0x4E, 0xf, 0xf, false));
    v += __builtin_bit_cast(float, __builtin_amdgcn_mov_dpp(__builtin_bit_cast(int, v), 0x141, 0xf, 0xf, false));
    return v;
}
__device__ __forceinline__ float silu_f(float v) { return v * __builtin_amdgcn_rcpf(1.f + __expf(-v)); }
__device__ __forceinline__ float wave_sum(float v) {
    v += __builtin_bit_cast(float, __builtin_amdgcn_mov_dpp(__builtin_bit_cast(int, v), 0xB1, 0xf, 0xf, false));
    v += __builtin_bit_cast(float, __builtin_amdgcn_mov_dpp(__builtin_bit_cast(int, v), 0x4E, 0xf, 0xf, false));
    v += __builtin_bit_cast(float, __builtin_amdgcn_mov_dpp(__builtin_bit_cast(int, v), 0x141, 0xf, 0xf, false));
    v += __builtin_bit_cast(float, __builtin_amdgcn_mov_dpp(__builtin_bit_cast(int, v), 0x140, 0xf, 0xf, false));
    const int b = __builtin_bit_cast(int, v);
    return (__builtin_bit_cast(float, __builtin_amdgcn_readlane(b, 0)) + __builtin_bit_cast(float, __builtin_amdgcn_readlane(b, 16))) + (__builtin_bit_cast(float, __builtin_amdgcn_readlane(b, 32)) + __builtin_bit_cast(float, __builtin_amdgcn_readlane(b, 48)));
}
__device__ __forceinline__ int otid() { int t = threadIdx.x; asm volatile("" : "+v"(t)); return t; }
__device__ __forceinline__ const float* inptr(const Params& p, int i) { asm volatile("" : "+s"(i)); return p.in[i]; }
__device__ __forceinline__ bf16_t* hb2_row(const Params& p, int row) { return row < NMAIN ? (bf16_t*)p.out + (size_t)row * D : (bf16_t*)(p.ws + WS_METAR) + (size_t)(row - NMAIN) * D; }
__device__ __forceinline__ bf16_t* y1_row(const Params& p, int row) { return row < NMAIN ? (bf16_t*)p.out + (size_t)(NMAIN + row) * D : (bf16_t*)(p.ws + WS_METAR + 524288) + (size_t)(row - NMAIN) * D; }
__device__ __forceinline__ f32x4 bf4(const u32x2 v) { return (f32x4){bf2f(v.x & 0xffff), bf2f(v.x >> 16), bf2f(v.y & 0xffff), bf2f(v.y >> 16)}; }

__device__ __forceinline__ int win_colmap(int np) {
    if (np < 2048) return np;
    if (np < 4160) return np + 8;
    if (np < 4168) return np - 4160 + 2048;
    if (np < 4176) return np;
    return -1;
}
template <class ColSrc>
__device__ __forceinline__ void transpose_tile(const ColSrc& cs, int ld, int k0, int n0, bf16_t* out, int Kout, LAS float* scr, int lane) {
    const float* colp = cs(n0 + (lane & 31));
#pragma unroll 8
    for (int i = 0; i < 32; ++i) { const int kk = 2 * i + (lane >> 5); scr[kk * 33 + (lane & 31)] = colp ? colp[(size_t)(k0 + kk) * ld] : 0.f; }
    asm volatile("s_waitcnt lgkmcnt(0)" ::: "memory");
    const int c = lane & 7;
#pragma unroll
    for (int j = 0; j < 4; ++j) {
        const int n = (lane >> 3) + 8 * j; const LAS float* s = scr + (8 * c) * 33 + n;
        u32x4 o; o.x = pk2(s[0 * 33], s[1 * 33]); o.y = pk2(s[2 * 33], s[3 * 33]); o.z = pk2(s[4 * 33], s[5 * 33]); o.w = pk2(s[6 * 33], s[7 * 33]);
        *(u32x4*)(out + (size_t)(n0 + n) * Kout + k0 + 8 * c) = o;
    }
    asm volatile("s_waitcnt lgkmcnt(0)" ::: "memory");
}


struct ColIdent { __device__ __forceinline__ int operator()(int n) const { return n; } };
template <class RowOf, class ColOf = ColIdent>
__device__ __forceinline__ void transpose_tile64(const float* W, int ld, int k0, int n0, bf16_t* out, int Kout, const RowOf& orow, LAS char* scr  , int lane, const ColOf& colof = ColOf()) {
    const int kr = lane >> 4, c4 = lane & 15;
    const int sc = colof(n0 + 4 * c4);
    f32x4 v[16];
#pragma unroll
    for (int i = 0; i < 16; ++i) v[i] = sc >= 0 ? *(const f32x4*)(W + (size_t)(k0 + 4 * i + kr) * ld + sc) : (f32x4){0.f, 0.f, 0.f, 0.f};
#pragma unroll
    for (int i = 0; i < 16; ++i)
#pragma unroll
        for (int e = 0; e < 4; ++e) *(LAS bf16_t*)(scr + (4 * c4 + e) * 144 + (4 * i + kr) * 2) = (bf16_t)f2bf(v[i][e]);
    asm volatile("s_waitcnt lgkmcnt(0)" ::: "memory");
#pragma unroll
    for (int j = 0; j < 8; ++j) {
        const int n = 8 * j + (lane >> 3), c = lane & 7;
        const u32x4 o = *(const LAS u32x4*)(scr + n * 144 + c * 16);
        *(u32x4*)(out + (size_t)orow(n0 + n) * Kout + k0 + 8 * c) = o;
    }
    asm volatile("s_waitcnt lgkmcnt(0)" ::: "memory");
}

__device__ __forceinline__ void phase0(const Params& p, LAS char* lds) {
    const int tid = otid(), lane = tid & 63, wid = tid >> 6;
    const int gw = blockIdx.x * 8 + wid, NGW = gridDim.x * 8;
    const float* x = inptr(p, I_X); const float* meta = inptr(p, I_META);
    bf16_t* Hb = (bf16_t*)(p.ws + WS_BF);
    for (int row = gw; row < MROWS; row += NGW) {
        const float* src = row < NMAIN ? x + (size_t)row * D : (row < NROWS ? meta + (size_t)(row - NMAIN) * D : nullptr);
        bf16_t* h2 = hb2_row(p, row);
#pragma unroll
        for (int j = 0; j < 4; ++j) {
            f32x4 v = src ? *(const f32x4*)(src + (lane + 64 * j) * 4) : (f32x4){0.f, 0.f, 0.f, 0.f};
            u32x2 o; o.x = pk2(v.x, v.y); o.y = pk2(v.z, v.w);
            *(u32x2*)(Hb + (size_t)row * D + (lane + 64 * j) * 4) = o;
            *(u32x2*)(h2 + (lane + 64 * j) * 4) = o;
        }
    }
    {
        LAS char* scr = lds + wid * 9216;
        constexpr int IT_IN = 16 * (NPROJP / 64), IT_OUT = 16 * 16, IT_L = IT_IN + IT_OUT;
        for (int it = gw; it < 2 * IT_L; it += NGW) {
            const int l = it / IT_L; int r = it % IT_L;
            if (r < IT_IN) {
                const int kb = r / (NPROJP / 64), nb = r % (NPROJP / 64);
                auto colof = [&](int np) -> int { const int cg = np & 255, lc = (np & ~255) + ((cg >> 5) & 3) * 64 + (cg >> 7) * 32 + (cg & 31); return win_colmap(lc); };
                auto orow = [&](int n) -> int { return n; };
                transpose_tile64(inptr(p, I_WIN) + (size_t)l * D * 4176, 4176, kb * 64, nb * 64, (bf16_t*)(p.ws + WS_WIN) + (size_t)l * NPROJP * D, D, orow, scr, lane, colof);
            } else {
                r -= IT_IN;
                const int kb = r >> 4, nb = r & 15;
                auto orow = [&](int n) -> int { return n; };
                transpose_tile64(inptr(p, I_WOUT) + (size_t)l * D * D, D, kb * 64, nb * 64, (bf16_t*)(p.ws + WS_WOUT) + (size_t)l * D * D, D, orow, scr, lane);
            }
        }
    }
    for (int idx = blockIdx.x * NTHREADS + tid; idx < 2 * D * 36; idx += gridDim.x * NTHREADS) {
        const int l = idx / (D * 36), r = idx % (D * 36), c = r % 36, q = r / 36, ln = q & 63, ji = q >> 6, j = ji >> 2, i = ji & 3, k = 4 * (ln + 64 * j) + i;
        ((float*)(p.ws + WS_RW))[idx] = c < 4 ? inptr(p, I_WGRP)[((size_t)l * D + k) * 4 + c] : inptr(p, I_WRTR)[((size_t)l * D + k) * 32 + (c - 4)];
    }
    float* rc = (float*)(p.ws + WS_ROPE); float* rs = rc + LT * 32;
    for (int i = blockIdx.x * NTHREADS + tid; i < LT * 32; i += gridDim.x * NTHREADS) {
        const int t = i >> 5, d = i & 31;
        const float ang = (float)t * p.rope_inv[d];
        const float k = rintf(ang * 0.15915494309189535f);
        float r = fmaf(-k, 6.2831854820251465f, ang); r = fmaf(-k, -1.7484556e-07f, r);
        rc[i] = __cosf(r); rs[i] = __sinf(r);
    }
}


constexpr int GT_PITCH = 144;
template <int MI, class ARow, class Epi>
__device__ __forceinline__ void gemm_tile(LAS char* lds, const ARow& arow, const bf16_t* __restrict__ Bt, int K, const Epi& epi) {
    constexpr int BM = 128 * MI, A_BYTES = BM * GT_PITCH, B_BYTES = 128 * GT_PITCH, STG = A_BYTES + B_BYTES;
    const int tid = otid(), lane = tid & 63, wid = tid >> 6, wm = wid >> 1, wn = wid & 1, r32 = lane & 31, hh = lane >> 5;
    const bf16_t* ap[2 * MI]; const bf16_t* bp[2];
#pragma unroll
    for (int i = 0; i < 2 * MI; ++i) { const int pi = tid + 512 * i; ap[i] = arow(pi >> 3) + (pi & 7) * 8; }
#pragma unroll
    for (int i = 0; i < 2; ++i) { const int pi = tid + 512 * i; bp[i] = Bt + (size_t)(pi >> 3) * K + (pi & 7) * 8; }
    const int wofs = (tid >> 3) * GT_PITCH + (tid & 7) * 16;
    u32x4 ra0[2 * MI], rb0[2], ra1[2 * MI], rb1[2];
    f32x16 acc[MI][2];
#pragma unroll
    for (int a = 0; a < MI; ++a)
#pragma unroll
        for (int b = 0; b < 2; ++b)
#pragma unroll
            for (int r = 0; r < 16; ++r) acc[a][b][r] = 0.f;
    const int nk = K >> 6;
#define GT_LOAD(RA, RB, kt_) do { _Pragma("unroll") for (int i = 0; i < 2 * MI; ++i) RA[i] = *(const u32x4*)(ap[i] + (kt_) * 64); _Pragma("unroll") for (int i = 0; i < 2; ++i) RB[i] = *(const u32x4*)(bp[i] + (kt_) * 64); } while (0)
#define GT_WRITE(RA, RB, st_) do { LAS char* sn_ = lds + (st_) * STG; _Pragma("unroll") for (int i = 0; i < 2 * MI; ++i) *(LAS u32x4*)(sn_ + wofs + i * 64 * GT_PITCH) = RA[i]; _Pragma("unroll") for (int i = 0; i < 2; ++i) *(LAS u32x4*)(sn_ + A_BYTES + wofs + i * 64 * GT_PITCH) = RB[i]; } while (0)
    const int aoff = (wm * 32 * MI + r32) * GT_PITCH + hh * 16, boff = A_BYTES + (wn * 64 + r32) * GT_PITCH + hh * 16;
#define GT_COMPUTE(st_) do { LAS char* st = lds + (st_) * STG; _Pragma("unroll") for (int s = 0; s < 4; ++s) { bf16x8 af[MI], bfr[2]; \
        _Pragma("unroll") for (int a = 0; a < MI; ++a) af[a] = *(const LAS bf16x8*)(st + aoff + a * 32 * GT_PITCH + s * 32); \
        _Pragma("unroll") for (int b = 0; b < 2; ++b) bfr[b] = *(const LAS bf16x8*)(st + boff + b * 32 * GT_PITCH + s * 32); \
        _Pragma("unroll") for (int a = 0; a < MI; ++a) _Pragma("unroll") for (int b = 0; b < 2; ++b) acc[a][b] = __builtin_amdgcn_mfma_f32_32x32x16_bf16(bfr[b], af[a], acc[a][b], 0, 0, 0); } } while (0)
    GT_LOAD(ra0, rb0, 0); GT_LOAD(ra1, rb1, 1);
    GT_WRITE(ra0, rb0, 0);
    __syncthreads();
    for (int kt = 0; kt < nk; kt += 2) {
        if (kt + 2 < nk) GT_LOAD(ra0, rb0, kt + 2);
        GT_COMPUTE(0);
        GT_WRITE(ra1, rb1, 1);
        __syncthreads();
        if (kt + 3 < nk) GT_LOAD(ra1, rb1, kt + 3);
        GT_COMPUTE(1);
        if (kt + 2 < nk) GT_WRITE(ra0, rb0, 0);
        __syncthreads();
    }
#undef GT_LOAD
#undef GT_WRITE
#undef GT_COMPUTE
#pragma unroll
    for (int a = 0; a < MI; ++a) epi(wm * 32 * MI + a * 32 + r32, wn * 64, acc[a][0], acc[a][1]);
}

namespace pg8 {
#define PG8_LAS __attribute__((address_space(3)))
typedef unsigned short bf16_t;
typedef short bf16x8 __attribute__((ext_vector_type(8)));
typedef float f32x4 __attribute__((ext_vector_type(4)));
typedef unsigned u32x4 __attribute__((ext_vector_type(4)));
constexpr int BM = 256, BK = 64, HALF = 128, HTB = HALF * BK * 2  , STAGE_BYTES = 8 * HTB, NXCD = 8, WGM = 8;

__host__ __device__ __forceinline__ int lds_byte(int r, int c) { const int st = (r >> 4) * 2 + (c >> 5), rr = r & 15, cc = c & 31, ob = rr * 64 + cc * 2; return st * 1024 + (ob ^ (((ob >> 9) & 1) << 5)); }
__host__ __device__ __forceinline__ void stage_rc(int b, int& R, int& C) { const int st = b / 1024, sb = b % 1024, swz = sb ^ (((sb >> 9) & 1) << 5); R = (st >> 1) * 16 + swz / 64; C = (st & 1) * 32 + (swz % 64) / 2; }
__host__ __device__ __forceinline__ int perm32(int rho) { const int n = rho >> 4, i = rho & 15; return 8 * (i >> 2) + 4 * n + (i & 3); }

struct Unit { int pm, pn; int ue = 0, um = 0; size_t bo = 0; };
struct Gemm { const bf16_t* A; const bf16_t* Bt; int M, N, K; };

struct StaticOrder {
    int nM, nN, nwg, G, c;
    __host__ __device__ void init(int M, int N, int G_, int c_) { nM = M / BM; nN = N / BM; nwg = nM * nN; G = G_; c = c_; }
    __host__ __device__ bool next(int i, Unit& u) const {
        const long L = (long)i * G + c; if (L >= nwg) return false;
        int wgid = (int)L; { const int q = nwg / NXCD, r = nwg % NXCD, xcd = wgid % NXCD, off = wgid / NXCD; wgid = (xcd < r ? xcd * (q + 1) : r * (q + 1) + (xcd - r) * q) + off; }
        const int nig = WGM * nN, gid = wgid / nig, fm = gid * WGM, gsz = (nM - fm) < WGM ? (nM - fm) : WGM;
        u.pm = fm + ((wgid % nig) % gsz); u.pn = (wgid % nig) / gsz; return true;
    }
    __device__ __forceinline__ void a_ready(const Unit&) const {}
    __device__ __forceinline__ void done(const Unit&) const {}
};


template <class Epi, class Sched, bool ALIGN_EPI = false, bool SP2 = false>
__device__ __forceinline__ void gemm_phase(PG8_LAS unsigned char* lds, const Gemm g, const Sched& S, const Epi& E) {
    const int tid = otid(), wid = __builtin_amdgcn_readfirstlane(tid >> 6), lane = tid & 63, wr = wid >> 2, wc = wid & 3, fr = lane & 15, fq = lane >> 4;
    const int K = g.K, nt = K / BK;
    unsigned voffA[2], voffB[2];
#pragma unroll
    for (int i = 0; i < 2; ++i) { int R, C; stage_rc(tid * 16 + i * 8192, R, C); const int Rb = Epi::PERM ? ((R & ~31) + perm32(R & 31)) : R;
        voffA[i] = (unsigned)(R * K + C) * 2u; voffB[i] = (unsigned)(Rb * K + C) * 2u; }
    const size_t kstep = (size_t)(BK * 2);
    const size_t hstep = (size_t)HALF * K * 2;
    const size_t tstep = 2 * hstep;
    const unsigned ldsw = (unsigned)wid * 1024u;
    const int aoff = lds_byte(wr * 64 + fr, fq * 8), boff = lds_byte(wc * 32 + fr, fq * 8);
#define PG8_SA(b, h) (((b) * 2 + (h)) * HTB)
#define PG8_SB(b, h) ((4 + (b) * 2 + (h)) * HTB)
#define PG8_STAGE(bufoff, gbase, voff) do { _Pragma("unroll") for (int _i = 0; _i < 2; ++_i) \
        __builtin_amdgcn_global_load_lds((const unsigned*)((const char*)(gbase) + (voff)[_i]), (PG8_LAS unsigned*)(lds + (bufoff) + ldsw + _i * 8192), 16, 0, 0); } while (0)
#define PG8_LDA(dst, b, h) do { _Pragma("unroll") for (int m = 0; m < 4; ++m) _Pragma("unroll") for (int k = 0; k < 2; ++k) dst[m][k] = *(const PG8_LAS bf16x8*)(lds + PG8_SA(b, h) + aoff + m * 2048 + k * 1024); } while (0)
#define PG8_LDB(dst, b, h) do { _Pragma("unroll") for (int n = 0; n < 2; ++n) _Pragma("unroll") for (int k = 0; k < 2; ++k) dst[n][k] = *(const PG8_LAS bf16x8*)(lds + PG8_SB(b, h) + boff + n * 2048 + k * 1024); } while (0)
#define PG8_MMA(ai, bj, At, Bt) do { __builtin_amdgcn_s_setprio(1); _Pragma("unroll") for (int m = 0; m < 4; ++m) _Pragma("unroll") for (int n = 0; n < 2; ++n) _Pragma("unroll") for (int k = 0; k < 2; ++k) \
        acc[ai][bj][m][n] = __builtin_amdgcn_mfma_f32_16x16x32_bf16(Bt[n][k], At[m][k], acc[ai][bj][m][n], 0, 0, 0); __builtin_amdgcn_s_setprio(0); } while (0)
#define PG8_WAIT_V(n) asm volatile("s_waitcnt vmcnt(" #n ")" ::: "memory")
#define PG8_WAIT_L(n) asm volatile("s_waitcnt lgkmcnt(" #n ")" ::: "memory")
#define PG8_BAR __builtin_amdgcn_s_barrier()
#define PG8_SCHED __builtin_amdgcn_sched_barrier(0)
    Unit cur, nxt; int ui = 0;
    if (!S.next(0, cur)) return;
    f32x4 acc[2][2][4][2];
#pragma unroll
    for (int a = 0; a < 2; ++a)
#pragma unroll
        for (int b = 0; b < 2; ++b)
#pragma unroll
            for (int m = 0; m < 4; ++m)
#pragma unroll
                for (int n = 0; n < 2; ++n) acc[a][b][m][n] = (f32x4){0.f, 0.f, 0.f, 0.f};
    bf16x8 At[4][2], B0[2][2], B1[2][2];
    const char* cA = (const char*)g.A + (size_t)cur.pm * tstep; const char* cB = (const char*)g.Bt + cur.bo + (size_t)cur.pn * tstep;
    S.a_ready(cur);
    if constexpr (SP2) {
        PG8_STAGE(PG8_SB(0, 0), cB, voffB); PG8_STAGE(PG8_SB(0, 1), cB + hstep, voffB); PG8_STAGE(PG8_SA(0, 0), cA, voffA); PG8_STAGE(PG8_SA(0, 1), cA + hstep, voffA);
        if (wr == 1) PG8_BAR;
        PG8_WAIT_V(2); PG8_BAR;
        PG8_STAGE(PG8_SB(1, 0), cB + kstep, voffB); PG8_STAGE(PG8_SA(1, 0), cA + kstep, voffA); PG8_STAGE(PG8_SB(1, 1), cB + hstep + kstep, voffB);
        PG8_WAIT_V(6); PG8_BAR;
    } else {
        PG8_STAGE(PG8_SB(0, 0), cB, voffB); PG8_STAGE(PG8_SA(0, 0), cA, voffA); PG8_STAGE(PG8_SB(0, 1), cB + hstep, voffB); PG8_STAGE(PG8_SA(0, 1), cA + hstep, voffA);
        if (wr == 1) PG8_BAR;
        PG8_WAIT_V(4); PG8_BAR;
        PG8_STAGE(PG8_SB(1, 0), cB + kstep, voffB); PG8_STAGE(PG8_SA(1, 0), cA + kstep, voffA); PG8_STAGE(PG8_SB(1, 1), cB + hstep + kstep, voffB);
        PG8_WAIT_V(6); PG8_BAR;
    }
    for (;;) {
        const bool has_next = S.next(ui + 1, nxt);
        const char* nA = has_next ? (const char*)g.A + (size_t)nxt.pm * tstep : cA; const char* nB = has_next ? (const char*)g.Bt + nxt.bo + (size_t)nxt.pn * tstep : cB;
        for (int t = 0; t < nt; t += 2) {
            const bool last = (t == nt - 2);
            const char* a1 = cA + (size_t)(t + 1) * kstep;
            const char* a2 = last ? nA : cA + (size_t)(t + 2) * kstep; const char* b2 = last ? nB : cB + (size_t)(t + 2) * kstep;
            const char* a3 = a2 + kstep; const char* b3 = b2 + kstep;
            if (last && has_next) S.a_ready(nxt);
            if constexpr (SP2) {
            PG8_LDB(B0, 0, 0); PG8_LDB(B1, 0, 1); PG8_SCHED; PG8_LDA(At, 0, 0); PG8_STAGE(PG8_SA(1, 1), a1 + hstep, voffA);
            PG8_WAIT_V(8); PG8_WAIT_L(0); PG8_BAR; PG8_MMA(0, 0, At, B0); PG8_MMA(0, 1, At, B1); PG8_BAR; PG8_SCHED;
            PG8_LDA(At, 0, 1); PG8_STAGE(PG8_SB(0, 0), b2, voffB); PG8_STAGE(PG8_SB(0, 1), b2 + hstep, voffB); PG8_STAGE(PG8_SA(0, 0), a2, voffA);
            PG8_WAIT_V(8); PG8_WAIT_L(0); PG8_BAR; PG8_MMA(1, 0, At, B0); PG8_MMA(1, 1, At, B1); PG8_BAR; PG8_SCHED;
            PG8_LDB(B0, 1, 0); PG8_LDB(B1, 1, 1); PG8_SCHED; PG8_LDA(At, 1, 0); PG8_STAGE(PG8_SA(0, 1), a2 + hstep, voffA);
            PG8_WAIT_V(8); PG8_WAIT_L(0); PG8_BAR; PG8_MMA(0, 0, At, B0); PG8_MMA(0, 1, At, B1); PG8_BAR; PG8_SCHED;
            PG8_LDA(At, 1, 1); PG8_STAGE(PG8_SB(1, 0), b3, voffB); PG8_STAGE(PG8_SB(1, 1), b3 + hstep, voffB); PG8_STAGE(PG8_SA(1, 0), a3, voffA);
            PG8_WAIT_V(8); PG8_WAIT_L(0); PG8_BAR; PG8_MMA(1, 0, At, B0); PG8_MMA(1, 1, At, B1); PG8_BAR; PG8_SCHED;
            } else {
            PG8_LDB(B0, 0, 0); PG8_SCHED; PG8_LDA(At, 0, 0); PG8_STAGE(PG8_SA(1, 1), a1 + hstep, voffA);
            PG8_WAIT_L(8); PG8_BAR; PG8_WAIT_L(0); PG8_MMA(0, 0, At, B0); PG8_BAR; PG8_SCHED;
            PG8_LDB(B1, 0, 1); PG8_STAGE(PG8_SB(0, 0), b2, voffB);
            PG8_BAR; PG8_WAIT_L(0); PG8_MMA(0, 1, At, B1); PG8_BAR;
            PG8_LDA(At, 0, 1); PG8_STAGE(PG8_SA(0, 0), a2, voffA);
            PG8_BAR; PG8_WAIT_L(0); PG8_MMA(1, 0, At, B0); PG8_BAR; PG8_SCHED;
            PG8_STAGE(PG8_SB(0, 1), b2 + hstep, voffB);
            PG8_WAIT_V(6); PG8_BAR; PG8_MMA(1, 1, At, B1); PG8_BAR;
            PG8_LDB(B0, 1, 0); PG8_SCHED; PG8_LDA(At, 1, 0); PG8_STAGE(PG8_SA(0, 1), a2 + hstep, voffA);
            PG8_WAIT_L(8); PG8_BAR; PG8_WAIT_L(0); PG8_MMA(0, 0, At, B0); PG8_BAR; PG8_SCHED;
            PG8_LDB(B1, 1, 1); PG8_STAGE(PG8_SB(1, 0), b3, voffB);
            PG8_BAR; PG8_WAIT_L(0); PG8_MMA(0, 1, At, B1); PG8_BAR;
            PG8_LDA(At, 1, 1); PG8_STAGE(PG8_SA(1, 0), a3, voffA);
            PG8_BAR; PG8_WAIT_L(0); PG8_MMA(1, 0, At, B0); PG8_BAR; PG8_SCHED;
            PG8_STAGE(PG8_SB(1, 1), b3 + hstep, voffB);
            PG8_WAIT_V(6); PG8_BAR; PG8_MMA(1, 1, At, B1); PG8_BAR;
            }
        }
        if constexpr (ALIGN_EPI) { if (wr == 0) PG8_BAR; }
        if constexpr (!Epi::AFTER_DRAIN) { E(acc, cur, wr, wc, fr, fq); S.done(cur); }
        if (!has_next) break;
#pragma unroll
        for (int a = 0; a < 2; ++a)
#pragma unroll
            for (int b = 0; b < 2; ++b)
#pragma unroll
                for (int m = 0; m < 4; ++m)
#pragma unroll
                    for (int n = 0; n < 2; ++n) acc[a][b][m][n] = (f32x4){0.f, 0.f, 0.f, 0.f};
        cur = nxt; cA = nA; cB = nB; ++ui;
        if constexpr (ALIGN_EPI) { if (wr == 1) PG8_BAR; }
    }
    PG8_WAIT_V(0);
    if constexpr (!ALIGN_EPI) { if (wr == 0) PG8_BAR; }
    PG8_BAR;
    if constexpr (Epi::AFTER_DRAIN) { E.fused(acc, cur, wr, wc, fr, fq, lds, wid, lane); S.done(cur); }
#undef PG8_SA
#undef PG8_SB
#undef PG8_STAGE
#undef PG8_LDA
#undef PG8_LDB
#undef PG8_MMA
#undef PG8_WAIT_V
#undef PG8_WAIT_L
#undef PG8_BAR
#undef PG8_SCHED
}
}

__device__ __forceinline__ void phaseG(const Params& p, int layer, int nrows, bool last) {
    const int tid = otid(), lane = tid & 63, wid = tid >> 6;
    const int gw = blockIdx.x * 8 + wid, NGW = gridDim.x * 8;
    const float* g = inptr(p, I_LN2G) + layer * D; const float* bb = inptr(p, I_LN2B) + layer * D;
    bf16_t* Hb = (bf16_t*)(p.ws + WS_BF);
    const bf16_t* EO = (const bf16_t*)(p.ws + WS_EO);
    u32x2 hn[4], e0n[4], e1n[4];
    auto pre = [&](int row) {
#pragma unroll
        for (int j = 0; j < 4; ++j) {
            hn[j] = *(const u32x2*)(Hb + (size_t)row * D + (lane + 64 * j) * 4);
            e0n[j] = *(const u32x2*)(EO + (size_t)row * D + (lane + 64 * j) * 4); e1n[j] = *(const u32x2*)(EO + (size_t)(MROWS + row) * D + (lane + 64 * j) * 4);
        }
    };
    if (gw < nrows) pre(gw);
    for (int row = gw; row < nrows; row += NGW) {
        f32x4 v[4]; float s = 0.f;
#pragma unroll
        for (int j = 0; j < 4; ++j) { v[j] = bf4(hn[j]) * ALPHA + bf4(e0n[j]) + bf4(e1n[j]); s += (v[j].x + v[j].y) + (v[j].z + v[j].w); }
        if (row + NGW < nrows) pre(row + NGW);
        const float mean = wave_sum(s) * (1.f / D); float s2 = 0.f;
#pragma unroll
        for (int j = 0; j < 4; ++j) { v[j] = v[j] - mean; s2 += (v[j].x * v[j].x + v[j].y * v[j].y) + (v[j].z * v[j].z + v[j].w * v[j].w); }
        const float rstd = 1.f / sqrtf(wave_sum(s2) * (1.f / D) + 1e-5f);
        bf16_t* h2 = hb2_row(p, row);
#pragma unroll
        for (int j = 0; j < 4; ++j) {
            const f32x4 gg = *(const f32x4*)(g + (lane + 64 * j) * 4), bv = *(const f32x4*)(bb + (lane + 64 * j) * 4);
            const f32x4 o = v[j] * rstd * gg + bv;
            if (last) *(f32x4*)(p.out + (size_t)row * D + (lane + 64 * j) * 4) = o;
            else {
                u32x2 ob; ob.x = pk2(o.x, o.y); ob.y = pk2(o.z, o.w);
                *(u32x2*)(Hb + (size_t)row * D + (lane + 64 * j) * 4) = ob;
                *(u32x2*)(h2 + (lane + 64 * j) * 4) = ob;
            }
        }
    }
}

__device__ __forceinline__ int row_pos(int row) { return row < NMAIN ? (row & (SEQ - 1)) + NMETA : (row < NROWS ? row - NMAIN : 0); }
constexpr float QSCALE = 0.125f * 1.4426950408889634f;
struct EpiInProj {
    static constexpr bool PERM = true, AFTER_DRAIN = false;
    unsigned char* ws;
    __device__ __forceinline__ void operator()(const pg8::f32x4 (&acc)[2][2][4][2], const pg8::Unit& u, int, int, int, int) const {
        const int tid_ = otid(), wid_ = __builtin_amdgcn_readfirstlane(tid_ >> 6), wr = wid_ >> 2, wc = wid_ & 3, fr = tid_ & 15, fq = (tid_ >> 4) & 3;
        const int pn = u.pn;
        bf16_t* PROJ = (bf16_t*)(ws + WS_PROJ); bf16_t* IK = (bf16_t*)(ws + WS_IK); float* PX = (float*)(ws + WS_PX); const float* rc = (const float*)(ws + WS_ROPE); const float* rs = rc + LT * 32;
        if (pn == 16 && wc >= 2) return;
#pragma unroll
        for (int ai = 0; ai < 2; ++ai)
#pragma unroll
            for (int m = 0; m < 4; ++m) {
                const int row = u.pm * 256 + ai * 128 + wr * 64 + m * 16 + fr;
                if (pn < 8 || pn == 12 || pn == 13) {
                    bf16_t* dst = PROJ + (size_t)row * 4096 + pn * 256 + wc * 64 + 8 * fq;
#pragma unroll
                    for (int bj = 0; bj < 2; ++bj) {
                        const pg8::f32x4 v0 = acc[ai][bj][m][0], v1 = acc[ai][bj][m][1];
                        *(u32x4*)(dst + 32 * bj) = (u32x4){pk2(v0[0], v0[1]), pk2(v0[2], v0[3]), pk2(v1[0], v1[1]), pk2(v1[2], v1[3])};
                    }
                } else if (pn < 16 || wc == 0) {
                    const int t = row_pos(row);
                    const float sc = pn < 10 ? QSCALE : 1.f;
                    bf16_t* dst = (pn < 16 ? PROJ + (size_t)row * 4096 + pn * 256 + wc * 64 : IK + (size_t)row * 64) + 8 * fq;
#pragma unroll
                    for (int n = 0; n < 2; ++n) {
                        const f32x4 cs = *(const f32x4*)(rc + t * 32 + 8 * fq + 4 * n), sn = *(const f32x4*)(rs + t * 32 + 8 * fq + 4 * n);
                        const pg8::f32x4 x1 = acc[ai][0][m][n], x2 = acc[ai][1][m][n];
                        const f32x4 a = (x1 * cs - x2 * sn) * sc, b = (x2 * cs + x1 * sn) * sc;
                        *(u32x2*)(dst + 4 * n) = (u32x2){pk2(a[0], a[1]), pk2(a[2], a[3])};
                        *(u32x2*)(dst + 32 + 4 * n) = (u32x2){pk2(b[0], b[1]), pk2(b[2], b[3])};
                    }
                } else if (fq < 2) {
                    float* dst = PX + (size_t)row * 16 + 8 * fq;
                    *(f32x4*)dst = acc[ai][0][m][0]; *(f32x4*)(dst + 4) = acc[ai][0][m][1];
                }
                asm volatile("" ::: "memory");
            }
    }
};
__device__ __forceinline__ void phaseA(const Params& p, int l, LAS char* lds) {
    pg8::Gemm g{(const bf16_t*)(p.ws + WS_BF), (const bf16_t*)(p.ws + WS_WIN) + (size_t)l * NPROJP * D, MROWS, NPROJP, D};
    pg8::StaticOrder S; S.init(MROWS, NPROJP, (int)gridDim.x, (int)blockIdx.x);
    EpiInProj E{p.ws};
    pg8::gemm_phase<EpiInProj, pg8::StaticOrder, true, true>((PG8_LAS unsigned char*)lds, g, S, E);
}

struct SchedCE {
    int mode; pg8::StaticOrder so; int G, c;
    __device__ __forceinline__ bool next(int i, pg8::Unit& u) const {
        if (mode == 0) return so.next(i, u);
        const LAS int* tab = (const LAS int*)(uintptr_t)131072;
        const int L = i * G + c, gt = L >> 2;
        if (gt >= tab[64]) return false;
        int lo = 0;
#pragma unroll
        for (int s = 16; s > 0; s >>= 1) if (tab[32 + lo + s] <= gt) lo += s;
        u.pm = gt; u.pn = L & 3; u.ue = lo; u.um = gt - tab[32 + lo]; u.bo = (size_t)lo * D * DEXP * 2;
        return true;
    }
    __device__ __forceinline__ void a_ready(const pg8::Unit&) const {}
    __device__ __forceinline__ void done(const pg8::Unit&) const {}
};
struct EpiCE {
    static constexpr bool PERM = true, AFTER_DRAIN = false;
    int mode; unsigned char* ws; bf16_t* dout;
    __device__ __forceinline__ void operator()(const pg8::f32x4 (&acc)[2][2][4][2], const pg8::Unit& u, int, int, int, int) const {
        const LAS int* tab = (const LAS int*)(uintptr_t)131072; const unsigned* list = (const unsigned*)(ws + WS_LIST); bf16_t* EO = (bf16_t*)(ws + WS_EO);
        const int tid_ = otid(), wid_ = __builtin_amdgcn_readfirstlane(tid_ >> 6), wr = wid_ >> 2, wc = wid_ & 3, fr = tid_ & 15, fq = (tid_ >> 4) & 3;
        const int cexp = mode ? tab[u.ue] : 0;
#pragma unroll
        for (int ai = 0; ai < 2; ++ai)
#pragma unroll
            for (int m = 0; m < 4; ++m) {
                const int rloc = ai * 128 + wr * 64 + m * 16 + fr, coff = u.pn * 256 + wc * 32 + 8 * fq;
                if (mode == 0) {
                    const size_t off = (size_t)(u.pm * 256 + rloc) * D + coff;
#pragma unroll
                    for (int bj = 0; bj < 2; ++bj) {
                        const u32x4 hv = *(const u32x4*)(dout + off + bj * 128);
                        const f32x4 y0 = bf4((u32x2){hv.x, hv.y}) * ALPHA + acc[ai][bj][m][0], y1v = bf4((u32x2){hv.z, hv.w}) * ALPHA + acc[ai][bj][m][1];
                        *(u32x4*)(dout + (size_t)NMAIN * D + off + bj * 128) = (u32x4){pk2(y0.x, y0.y), pk2(y0.z, y0.w), pk2(y1v.x, y1v.y), pk2(y1v.z, y1v.w)};
                    }
                } else {
                    const int idx = u.um * 256 + rloc;
                    if (idx < cexp) {
                        const unsigned ent = list[u.ue * LIST_CAP + idx];
                        bf16_t* dst = EO + ((size_t)(ent & 1u) * MROWS + (ent >> 1)) * D + coff;
#pragma unroll
                        for (int bj = 0; bj < 2; ++bj) {
                            const pg8::f32x4 v0 = acc[ai][bj][m][0], v1 = acc[ai][bj][m][1];
                            *(u32x4*)(dst + 128 * bj) = (u32x4){pk2(v0[0], v0[1]), pk2(v0[2], v0[3]), pk2(v1[0], v1[1]), pk2(v1[2], v1[3])};
                        }
                    }
                }
                asm volatile("" ::: "memory");
            }
    }
};
constexpr int MOE_TAB_EARLY = 131072;
__device__ __forceinline__ void moe_build_table(const unsigned* cnt, LAS int* tab);
__device__ __forceinline__ void phaseCE(const Params& p, int l, LAS char* lds, int mode) {
    const int tid = otid(), lane = tid & 63, wid = tid >> 6;
    const bf16_t* MIX = (const bf16_t*)(p.ws + WS_BF);
    const bf16_t* Wt = (const bf16_t*)(p.ws + WS_WOUT) + (size_t)l * D * D;
    {
        LAS int* tab = (LAS int*)(lds + MOE_TAB_EARLY);
        if (mode) moe_build_table((const unsigned*)(p.ws + WS_CTL) + 256 + l * 64, tab);
        pg8::Gemm g{mode ? (const bf16_t*)(p.ws + WS_HID) : MIX, mode ? (const bf16_t*)(p.ws + WS_W2T) : Wt, mode ? 0 : NMAIN, D, mode ? DEXP : D};
        SchedCE S; S.mode = mode; S.so.init(NMAIN, D, (int)gridDim.x, (int)blockIdx.x); S.G = (int)gridDim.x; S.c = (int)blockIdx.x;
        EpiCE E{mode, p.ws, (bf16_t*)p.out};
        pg8::gemm_phase<EpiCE, SchedCE, true, true>((PG8_LAS unsigned char*)lds, g, S, E);
    }
    if (mode) return;
    if (l == 0 && wid == 0 && blockIdx.x < 64) {
        typedef float f32x4v __attribute__((ext_vector_type(4)));
        const int n0 = blockIdx.x * 16, r16 = lane & 15, q = lane >> 4;
        const bf16_t* ar = MIX + (size_t)(NMAIN + r16) * D + 8 * q; const bf16_t* br = Wt + (size_t)(n0 + r16) * D + 8 * q;
        f32x4v acc = (f32x4v){0.f, 0.f, 0.f, 0.f};
        for (int s = 0; s < 32; ++s) { const bf16x8 a = *(const bf16x8*)(ar + 32 * s), bq = *(const bf16x8*)(br + 32 * s); acc = __builtin_amdgcn_mfma_f32_16x16x32_bf16(bq, a, acc, 0, 0, 0); }
        const size_t moff = (size_t)r16 * D + n0 + 4 * q;
        const f32x4 y = bf4(*(const u32x2*)(hb2_row(p, NMAIN) + moff)) * ALPHA + (f32x4){acc[0], acc[1], acc[2], acc[3]};
        *(u32x2*)(y1_row(p, NMAIN) + moff) = (u32x2){pk2(y.x, y.y), pk2(y.z, y.w)};
    }
}


__device__ __forceinline__ void mm16_acc(float (&c)[4], const LAS float* A, int pa, const LAS float* B, int pb, int lane) {
    const int r0 = 4 * (lane >> 4), cc = lane & 15;
    float bc[16];
#pragma unroll
    for (int k = 0; k < 16; ++k) bc[k] = B[k * pb + cc];
#pragma unroll
    for (int r = 0; r < 4; ++r) {
        const LAS float* ar = A + (r0 + r) * pa;
        const f32x4 a0 = *(const LAS f32x4*)ar, a1 = *(const LAS f32x4*)(ar + 4), a2 = *(const LAS f32x4*)(ar + 8), a3 = *(const LAS f32x4*)(ar + 12);
        c[r] += (a0.x * bc[0] + a0.y * bc[1] + a0.z * bc[2] + a0.w * bc[3]) + (a1.x * bc[4] + a1.y * bc[5] + a1.z * bc[6] + a1.w * bc[7])
              + (a2.x * bc[8] + a2.y * bc[9] + a2.z * bc[10] + a2.w * bc[11]) + (a3.x * bc[12] + a3.y * bc[13] + a3.z * bc[14] + a3.w * bc[15]);
    }
}
__device__ __forceinline__ void mm16_store(const float (&c)[4], float sgn, LAS float* Dst, int pd, int lane) {
    const int r0 = 4 * (lane >> 4), cc = lane & 15;
#pragma unroll
    for (int r = 0; r < 4; ++r) Dst[(r0 + r) * pd + cc] = sgn * c[r];
}
__device__ __forceinline__ int tok_row(int b, int t) { return t < NMETA ? NMAIN + t : b * SEQ + (t - NMETA); }
constexpr int DN_ITEM_BYTES = 73728;
constexpr int DN_W = 0, DN_QD = 16384, DN_KDT = 32768, DN_U = 49152, DN_AQK = 65536;
constexpr int DL_KB = 0, DL_KN = 17408, DL_QS = 34816, DL_VBT = 52224, DL_KBDT = 70656, DL_A = 89088, DL_THI = 106496, DL_TLO = 115712, DL_TF = 124928, DL_BETA = 142336, DL_GC = 142592, DL_CW = 142848  , DL_RAW = 89088  ;
__device__ __forceinline__ void dn_intra_item(const Params& p, int l, int item, LAS char* lds) {
    const int tid = otid(), lane = tid & 63, wid = tid >> 6, r32 = lane & 31, hh = lane >> 5;
    const int n = item % 33, bh = item / 33, h = bh & 3, b = bh >> 2;
    const bf16_t* PROJ = (const bf16_t*)(p.ws + WS_PROJ); const float* PX = (const float*)(p.ws + WS_PX);
    unsigned char* ib = p.ws + WS_X + (size_t)item * DN_ITEM_BYTES;
    LAS float* Lbeta = (LAS float*)(lds + DL_BETA); LAS float* Lgc = (LAS float*)(lds + DL_GC);
    if (wid == 0) {
        const int t = (n == 0) ? lane - 48 : NMETA + 64 * (n - 1) + lane; const bool valid = t >= 0;
        const int row = valid ? tok_row(b, t) : 0;
        const float bl = PX[row * 16 + h], al = PX[row * 16 + 4 + h];
        const float beta = valid ? 1.f / (1.f + __expf(-bl)) : 0.f;
        const float x = al + inptr(p, I_DTB)[l * 4 + h]; const float ex = __expf(x); const float sp = x > 20.f ? x : (ex < 0.01f ? ex * (1.f - ex * (0.5f - ex * 0.33333334f)) : __logf(1.f + ex));
        const float g = valid ? -__expf(inptr(p, I_ALOG)[l * 4 + h]) * sp : 0.f;
        float gc = g;
#pragma unroll
        for (int o = 1; o < 64; o <<= 1) { const float y = __shfl_up(gc, o); if (lane >= o) gc += y; }
        Lbeta[lane] = beta; Lgc[lane] = gc;
        if (lane == 63) ((float*)(p.ws + WS_GL))[item] = gc;
    }
    {
        const int tfirst = (n == 0) ? -48 : NMETA + 64 * (n - 1);
        u32x4 rr[7];
#pragma unroll
        for (int k = 0; k < 7; ++k) {
            const int pi = tid + 512 * k, r = pi / 48, c = pi % 48, t = tfirst - 3 + r;
            rr[k] = (pi < 67 * 48 && t >= 0) ? *(const u32x4*)(PROJ + (size_t)tok_row(b, t) * 4096 + (c >> 4) * 512 + h * 128 + (c & 15) * 8) : (u32x4){0u, 0u, 0u, 0u};
        }
        f32x4 wv = (f32x4){0.f, 0.f, 0.f, 0.f};
        if (tid < 384) { const int j = tid / 96, c4 = tid % 96; wv = *(const f32x4*)(inptr(p, I_CONV) + ((size_t)l * 4 + j) * 1536 + (c4 >> 5) * 512 + h * 128 + (c4 & 31) * 4); }
#pragma unroll
        for (int k = 0; k < 7; ++k) { const int pi = tid + 512 * k, r = pi / 48, c = pi % 48; if (pi < 67 * 48) *(LAS u32x4*)(lds + DL_RAW + r * 784 + ((c >> 4) * 128 + (c & 15) * 8) * 2) = rr[k]; }
        if (tid < 384) { const int j = tid / 96, c4 = tid % 96; *(LAS f32x4*)(lds + DL_CW + (j * 384 + (c4 >> 5) * 128 + (c4 & 31) * 4) * 4) = wv; }
    }
    __syncthreads();
    {
        const int i = tid >> 3, part = tid & 7;
        const float beta = Lbeta[i], gc = Lgc[i], gl = Lgc[63];
        const float eg = __expf(gc), egl = __expf(gl - gc);
        auto conv = [&](int ten, float (&y)[16]) {
#pragma unroll
            for (int e = 0; e < 16; ++e) y[e] = 0.f;
#pragma unroll
            for (int j = 0; j < 4; ++j) {
                const LAS char* rp = lds + DL_RAW + (i + j) * 784 + (ten * 128 + 16 * part) * 2;
                const u32x4 d0 = *(const LAS u32x4*)rp, d1 = *(const LAS u32x4*)(rp + 16);
                const LAS float* wj = (const LAS float*)(lds + DL_CW) + j * 384 + ten * 128 + 16 * part;
#pragma unroll
                for (int e4 = 0; e4 < 4; ++e4) {
                    const f32x4 w = *(const LAS f32x4*)(wj + 4 * e4);
                    const unsigned lo = e4 < 2 ? d0[2 * e4] : d1[2 * e4 - 4], hi = e4 < 2 ? d0[2 * e4 + 1] : d1[2 * e4 - 3];
                    y[4 * e4 + 0] += w.x * bf2f(lo & 0xffff); y[4 * e4 + 1] += w.y * bf2f(lo >> 16);
                    y[4 * e4 + 2] += w.z * bf2f(hi & 0xffff); y[4 * e4 + 3] += w.w * bf2f(hi >> 16);
                }
            }
#pragma unroll
            for (int e = 0; e < 16; ++e) y[e] = silu_f(y[e]);
        };
        {
            const int t = (n == 0) ? i - 48 : NMETA + 64 * (n - 1) + i;
            if (t >= 0 && (n > 0 || b == 0)) {
                bf16_t* zp = (bf16_t*)(p.ws + WS_PROJ) + (size_t)tok_row(b, t) * 4096 + 1536 + h * 128 + 16 * part;
                const float* ng = inptr(p, I_DNG) + l * 128 + 16 * part;
                const u32x4 z0 = *(const u32x4*)zp, z1 = *(const u32x4*)(zp + 8);
                unsigned po[8];
#pragma unroll
                for (int e = 0; e < 8; ++e) {
                    const unsigned zz = e < 4 ? z0[e] : z1[e - 4];
                    const float za = bf2f(zz & 0xffff), zb = bf2f(zz >> 16);
                    po[e] = pk2(ng[2 * e] * silu_f(za), ng[2 * e + 1] * silu_f(zb));
                }
                *(u32x4*)zp = (u32x4){po[0], po[1], po[2], po[3]}; *(u32x4*)(zp + 8) = (u32x4){po[4], po[5], po[6], po[7]};
            }
        }
        {
            float y[16]; conv(2, y);
#pragma unroll
            for (int e = 0; e < 16; ++e) *(LAS bf16_t*)(lds + DL_VBT + (16 * part + e) * 144 + i * 2) = (bf16_t)f2bf(y[e] * beta);
        }
        {
            float y[16]; conv(0, y);
            float sq = 0.f;
#pragma unroll
            for (int e = 0; e < 16; ++e) sq += y[e] * y[e];
            sq = sum8_dpp(sq);
            const float rq = rsqrtf(sq + 1e-6f) * 0.08838834764831845f;
            unsigned pq[8], pqd[8];
#pragma unroll
            for (int e = 0; e < 8; ++e) { const float q0 = y[2 * e] * rq, q1 = y[2 * e + 1] * rq; pq[e] = pk2(q0, q1); pqd[e] = pk2(q0 * eg, q1 * eg); }
            *(LAS u32x4*)(lds + DL_QS + i * 272 + part * 32) = (u32x4){pq[0], pq[1], pq[2], pq[3]}; *(LAS u32x4*)(lds + DL_QS + i * 272 + part * 32 + 16) = (u32x4){pq[4], pq[5], pq[6], pq[7]};
            bf16_t* QD = (bf16_t*)(ib + DN_QD) + i * 128 + part * 16;
            *(u32x4*)QD = (u32x4){pqd[0], pqd[1], pqd[2], pqd[3]}; *(u32x4*)(QD + 8) = (u32x4){pqd[4], pqd[5], pqd[6], pqd[7]};
        }
        {
            float y[16]; conv(1, y);
            float sk = 0.f;
#pragma unroll
            for (int e = 0; e < 16; ++e) sk += y[e] * y[e];
            sk = sum8_dpp(sk);
            const float rk = rsqrtf(sk + 1e-6f);
            unsigned pk[8], pkb[8];
#pragma unroll
            for (int e = 0; e < 8; ++e) { const float k0 = y[2 * e] * rk, k1 = y[2 * e + 1] * rk; pk[e] = pk2(k0, k1); pkb[e] = pk2(k0 * beta, k1 * beta); }
            *(LAS u32x4*)(lds + DL_KN + i * 272 + part * 32) = (u32x4){pk[0], pk[1], pk[2], pk[3]}; *(LAS u32x4*)(lds + DL_KN + i * 272 + part * 32 + 16) = (u32x4){pk[4], pk[5], pk[6], pk[7]};
            *(LAS u32x4*)(lds + DL_KB + i * 272 + part * 32) = (u32x4){pkb[0], pkb[1], pkb[2], pkb[3]}; *(LAS u32x4*)(lds + DL_KB + i * 272 + part * 32 + 16) = (u32x4){pkb[4], pkb[5], pkb[6], pkb[7]};
            bf16_t* KDT = (bf16_t*)(ib + DN_KDT);
#pragma unroll
            for (int e = 0; e < 16; ++e) {
                const int c = 16 * part + e; const float kn = y[e] * rk;
                *(LAS bf16_t*)(lds + DL_KBDT + c * 144 + i * 2) = (bf16_t)f2bf(kn * beta * eg);
                KDT[c * 64 + i] = (bf16_t)f2bf(kn * egl);
            }
        }
    }
    __syncthreads();
    {
        const int mat = wid >> 2, mb = (wid >> 1) & 1, nb = wid & 1;
        f32x16 acc;
#pragma unroll
        for (int r = 0; r < 16; ++r) acc[r] = 0.f;
        if (mb >= nb) {
            LAS char* ab = lds + (mat ? DL_QS : DL_KB) + (32 * mb + r32) * 272 + 16 * hh; LAS char* bb = lds + DL_KN + (32 * nb + r32) * 272 + 16 * hh;
#pragma unroll
            for (int s = 0; s < 8; ++s) acc = __builtin_amdgcn_mfma_f32_32x32x16_bf16(*(const LAS bf16x8*)(bb + 32 * s), *(const LAS bf16x8*)(ab + 32 * s), acc, 0, 0, 0);
        }
        const int i = 32 * mb + r32; const float gi = Lgc[i];
#pragma unroll
        for (int g = 0; g < 4; ++g) {
            const int j0 = 32 * nb + 8 * g + 4 * hh; const f32x4 gj = *(const LAS f32x4*)(Lgc + j0);
            float v[4];
#pragma unroll
            for (int jj = 0; jj < 4; ++jj) { const int j = j0 + jj; const bool keep = mat ? (i >= j) : (i > j); v[jj] = keep ? acc[4 * g + jj] * __expf(gi - gj[jj]) : 0.f; }
            if (mat == 0) *(LAS f32x4*)(lds + DL_A + i * 272 + j0 * 4) = (f32x4){v[0], v[1], v[2], v[3]};
            else { u32x2 o; o.x = pk2(v[0], v[1]); o.y = pk2(v[2], v[3]); *(u32x2*)((bf16_t*)(ib + DN_AQK) + i * 64 + j0) = o; }
        }
    }
    __syncthreads();
    {
        const LAS float* A = (const LAS float*)(lds + DL_A); LAS float* TF = (LAS float*)(lds + DL_TF);
        LAS float* XT = (LAS float*)(lds + DL_THI);
        if (wid == 0) {
            const int blk = lane >> 4, c = lane & 15;
            f32x4 ad[16][4];
#pragma unroll
            for (int ii = 1; ii < 16; ++ii)
#pragma unroll
                for (int c4 = 0; c4 < 4; ++c4) if (4 * c4 < ii) ad[ii][c4] = *(const LAS f32x4*)(A + (16 * blk + ii) * 68 + 16 * blk + 4 * c4);
            float t[16];
#pragma unroll
            for (int ii = 0; ii < 16; ++ii) {
                float acc = (c == ii) ? 1.f : 0.f;
#pragma unroll
                for (int jj = 0; jj < ii; ++jj) acc -= ad[ii][jj >> 2][jj & 3] * t[jj];
                t[ii] = acc;
            }
#pragma unroll
            for (int ii = 0; ii < 16; ++ii) TF[(16 * blk + ii) * 68 + 16 * blk + c] = t[ii];
        }
        __syncthreads();
#define BLK(M, i, j) ((M) + (16 * (i)) * 68 + 16 * (j))
        if (wid < 3) { float c[4] = {0.f, 0.f, 0.f, 0.f}; mm16_acc(c, BLK(A, wid + 1, wid), 68, BLK(TF, wid, wid), 68, lane); mm16_store(c, 1.f, XT + wid * 320, 20, lane); }
        __syncthreads();
        if (wid < 3) { float c[4] = {0.f, 0.f, 0.f, 0.f}; mm16_acc(c, BLK(TF, wid + 1, wid + 1), 68, XT + wid * 320, 20, lane); mm16_store(c, -1.f, BLK(TF, wid + 1, wid), 68, lane); }
        __syncthreads();
        if (wid < 2) { float c[4] = {0.f, 0.f, 0.f, 0.f}; mm16_acc(c, BLK(A, wid + 2, wid), 68, BLK(TF, wid, wid), 68, lane); mm16_acc(c, BLK(A, wid + 2, wid + 1), 68, BLK(TF, wid + 1, wid), 68, lane); mm16_store(c, 1.f, XT + wid * 320, 20, lane); }
        __syncthreads();
        if (wid < 2) { float c[4] = {0.f, 0.f, 0.f, 0.f}; mm16_acc(c, BLK(TF, wid + 2, wid + 2), 68, XT + wid * 320, 20, lane); mm16_store(c, -1.f, BLK(TF, wid + 2, wid), 68, lane); }
        __syncthreads();
        if (wid == 0) { float c[4] = {0.f, 0.f, 0.f, 0.f}; mm16_acc(c, BLK(A, 3, 0), 68, BLK(TF, 0, 0), 68, lane); mm16_acc(c, BLK(A, 3, 1), 68, BLK(TF, 1, 0), 68, lane); mm16_acc(c, BLK(A, 3, 2), 68, BLK(TF, 2, 0), 68, lane); mm16_store(c, 1.f, XT, 20, lane); }
        __syncthreads();
        if (wid == 0) { float c[4] = {0.f, 0.f, 0.f, 0.f}; mm16_acc(c, BLK(TF, 3, 3), 68, XT, 20, lane); mm16_store(c, -1.f, BLK(TF, 3, 0), 68, lane); }
#undef BLK
    }
    __syncthreads();
    {
        const int i = tid >> 3, c0 = (tid & 7) * 8;
        const f32x4 a = *(const LAS f32x4*)(lds + DL_TF + (i * 68 + c0) * 4), c = *(const LAS f32x4*)(lds + DL_TF + (i * 68 + c0 + 4) * 4);
        const bool up = (c0 >> 4) > (i >> 4);
        const float v[8] = {up ? 0.f : a.x, up ? 0.f : a.y, up ? 0.f : a.z, up ? 0.f : a.w, up ? 0.f : c.x, up ? 0.f : c.y, up ? 0.f : c.z, up ? 0.f : c.w};
        unsigned hi[8]; float lo[8];
#pragma unroll
        for (int e = 0; e < 8; ++e) { hi[e] = f2bf(v[e]); lo[e] = v[e] - bf2f((unsigned short)hi[e]); }
        *(LAS u32x4*)(lds + DL_THI + i * 144 + c0 * 2) = (u32x4){hi[0] | (hi[1] << 16), hi[2] | (hi[3] << 16), hi[4] | (hi[5] << 16), hi[6] | (hi[7] << 16)};
        *(LAS u32x4*)(lds + DL_TLO + i * 144 + c0 * 2) = (u32x4){pk2(lo[0], lo[1]), pk2(lo[2], lo[3]), pk2(lo[4], lo[5]), pk2(lo[6], lo[7])};
    }
    __syncthreads();
    {
        const int mb = wid >> 2, nb = wid & 3;
        LAS char* th = lds + DL_THI + (32 * mb + r32) * 144 + 16 * hh; LAS char* tl = lds + DL_TLO + (32 * mb + r32) * 144 + 16 * hh;
        LAS char* vb = lds + DL_VBT + (32 * nb + r32) * 144 + 16 * hh; LAS char* kb = lds + DL_KBDT + (32 * nb + r32) * 144 + 16 * hh;
        f32x16 u, w;
#pragma unroll
        for (int r = 0; r < 16; ++r) { u[r] = 0.f; w[r] = 0.f; }
#pragma unroll
        for (int s = 0; s < 4; ++s) {
            const bf16x8 ah = *(const LAS bf16x8*)(th + 32 * s), al = *(const LAS bf16x8*)(tl + 32 * s), bv = *(const LAS bf16x8*)(vb + 32 * s), bk = *(const LAS bf16x8*)(kb + 32 * s);
            u = __builtin_amdgcn_mfma_f32_32x32x16_bf16(ah, bv, u, 0, 0, 0); u = __builtin_amdgcn_mfma_f32_32x32x16_bf16(al, bv, u, 0, 0, 0);
            w = __builtin_amdgcn_mfma_f32_32x32x16_bf16(bk, ah, w, 0, 0, 0); w = __builtin_amdgcn_mfma_f32_32x32x16_bf16(bk, al, w, 0, 0, 0);
        }
        unsigned pu[8];
#pragma unroll
        for (int e = 0; e < 8; ++e) pu[e] = pk2(u[2 * e], u[2 * e + 1]);
        bf16_t* U = (bf16_t*)(ib + DN_U) + ((mb * 4 + nb) * 64 + lane) * 16;
        *(u32x4*)U = (u32x4){pu[0], pu[1], pu[2], pu[3]}; *(u32x4*)(U + 8) = (u32x4){pu[4], pu[5], pu[6], pu[7]};
        bf16_t* W = (bf16_t*)(ib + DN_W) + (32 * mb + r32) * 128 + 32 * nb + 4 * hh;
#pragma unroll
        for (int g = 0; g < 4; ++g) { u32x2 o; o.x = pk2(-w[4 * g], -w[4 * g + 1]); o.y = pk2(-w[4 * g + 2], -w[4 * g + 3]); *(u32x2*)(W + 8 * g) = o; }
    }
    __syncthreads();
}

constexpr int SL_ST = 0, SL_VNT = 34816, SL_O = 53248, SL_WB = 87040, SL_QDB = 104448, SL_KDTB = 121856, SL_AQKB = 140288;
__device__ __forceinline__ void dn_scan(const Params& p, int l, int b, int h, LAS char* lds) {
    const int tid = otid(), lane = tid & 63, wid = tid >> 6, r32 = lane & 31, hh = lane >> 5;
    for (int i = tid; i < 34816 / 4; i += NTHREADS) ((LAS unsigned*)(lds + SL_ST))[i] = 0u;
    f32x16 S[2];
#pragma unroll
    for (int r = 0; r < 16; ++r) { S[0][r] = 0.f; S[1][r] = 0.f; }
    const int mb = wid >> 2, nb = wid & 3;
    const int vb = wid & 3, kb2 = wid >> 2;
    const bf16_t* PROJ = (const bf16_t*)(p.ws + WS_PROJ); bf16_t* MIX = (bf16_t*)(p.ws + WS_BF);
    const float* ng = inptr(p, I_DNG) + l * 128;
    const int ni = tid >> 3, npart = tid & 7;
    struct PfSet { u32x4 w[2], q[2], k[2], a, u[2]; float g; };
    PfSet s0, s1; u32x4 zn0, zn1;
    auto gload = [&](PfSet& r, int n) {
        const int item = (b * 4 + h) * 33 + n;
        const unsigned char* ib = p.ws + WS_X + (size_t)item * DN_ITEM_BYTES;
#pragma unroll
        for (int i = 0; i < 2; ++i) {
            const int pi = tid + 512 * i;
            r.w[i] = *(const u32x4*)(ib + DN_W + (pi >> 4) * 256 + (pi & 15) * 16);
            r.q[i] = *(const u32x4*)(ib + DN_QD + (pi >> 4) * 256 + (pi & 15) * 16);
            r.k[i] = *(const u32x4*)(ib + DN_KDT + (pi >> 3) * 128 + (pi & 7) * 16);
        }
        r.a = *(const u32x4*)(ib + DN_AQK + (tid >> 3) * 128 + (tid & 7) * 16);
        const bf16_t* U = (const bf16_t*)(ib + DN_U) + ((mb * 4 + nb) * 64 + lane) * 16;
        r.u[0] = *(const u32x4*)U; r.u[1] = *(const u32x4*)(U + 8);
        r.g = ((const float*)(p.ws + WS_GL))[item];
    };
    auto zload = [&](int n) {
        const int t = (n == 0) ? ni - 48 : NMETA + 64 * (n - 1) + ni;
        const bf16_t* zp = PROJ + (size_t)tok_row(b, t < 0 ? 0 : t) * 4096 + 1536 + h * 128 + 16 * npart;
        zn0 = *(const u32x4*)zp; zn1 = *(const u32x4*)(zp + 8);
    };
    auto lwrite = [&](const PfSet& r) {
#pragma unroll
        for (int i = 0; i < 2; ++i) {
            const int pi = tid + 512 * i;
            *(LAS u32x4*)(lds + SL_WB + (pi >> 4) * 272 + (pi & 15) * 16) = r.w[i];
            *(LAS u32x4*)(lds + SL_QDB + (pi >> 4) * 272 + (pi & 15) * 16) = r.q[i];
            *(LAS u32x4*)(lds + SL_KDTB + (pi >> 3) * 144 + (pi & 7) * 16) = r.k[i];
        }
        *(LAS u32x4*)(lds + SL_AQKB + (tid >> 3) * 144 + (tid & 7) * 16) = r.a;
    };
    gload(s0, 0); zload(0); lwrite(s0);
    u32x4 cU0 = s0.u[0], cU1 = s0.u[1], cZ0 = zn0, cZ1 = zn1; float cG = s0.g;
    __syncthreads();
    auto chunk = [&](int n, PfSet& fr, PfSet& nx) {
        const bool more = n + 1 < 33;
        if (more) { gload(nx, n + 1); zload(n + 1); }
        const float egl = __expf(cG);
        bf16x8 sf[8];
        {
            LAS char* sp = lds + SL_ST + (32 * nb + r32) * 272 + 16 * hh;
#pragma unroll
            for (int s = 0; s < 8; ++s) sf[s] = *(const LAS bf16x8*)(sp + 32 * s);
            f32x16 vn;
#pragma unroll
            for (int e = 0; e < 4; ++e) { vn[2 * e] = bf2f(cU0[e] & 0xffff); vn[2 * e + 1] = bf2f(cU0[e] >> 16); vn[8 + 2 * e] = bf2f(cU1[e] & 0xffff); vn[8 + 2 * e + 1] = bf2f(cU1[e] >> 16); }
            LAS char* wp = lds + SL_WB + (32 * mb + r32) * 272 + 16 * hh;
#pragma unroll
            for (int s = 0; s < 8; ++s) vn = __builtin_amdgcn_mfma_f32_32x32x16_bf16(*(const LAS bf16x8*)(wp + 32 * s), sf[s], vn, 0, 0, 0);
#pragma unroll
            for (int g = 0; g < 4; ++g) { u32x2 o; o.x = pk2(vn[4 * g], vn[4 * g + 1]); o.y = pk2(vn[4 * g + 2], vn[4 * g + 3]); *(LAS u32x2*)(lds + SL_VNT + (32 * nb + r32) * 144 + (32 * mb + 8 * g + 4 * hh) * 2) = o; }
        }
        __syncthreads();
        {
            f32x16 o;
#pragma unroll
            for (int r = 0; r < 16; ++r) o[r] = 0.f;
            LAS char* qp = lds + SL_QDB + (32 * mb + r32) * 272 + 16 * hh;
#pragma unroll
            for (int s = 0; s < 8; ++s) o = __builtin_amdgcn_mfma_f32_32x32x16_bf16(*(const LAS bf16x8*)(qp + 32 * s), sf[s], o, 0, 0, 0);
            LAS char* ap = lds + SL_AQKB + (32 * mb + r32) * 144 + 16 * hh;
            LAS char* vp = lds + SL_VNT + (32 * nb + r32) * 144 + 16 * hh;
#pragma unroll
            for (int s = 0; s < 4; ++s) o = __builtin_amdgcn_mfma_f32_32x32x16_bf16(*(const LAS bf16x8*)(ap + 32 * s), *(const LAS bf16x8*)(vp + 32 * s), o, 0, 0, 0);
#pragma unroll
            for (int r = 0; r < 16; ++r) *(LAS float*)(lds + SL_O + ((32 * mb + (r & 3) + 8 * (r >> 2) + 4 * hh) * 132 + 32 * nb + r32) * 4) = o[r];
            LAS char* vp4 = lds + SL_VNT + (32 * vb + r32) * 144 + 16 * hh;
            bf16x8 vf[4];
#pragma unroll
            for (int s = 0; s < 4; ++s) vf[s] = *(const LAS bf16x8*)(vp4 + 32 * s);
#pragma unroll
            for (int q = 0; q < 2; ++q) {
                LAS char* kp = lds + SL_KDTB + (32 * (2 * kb2 + q) + r32) * 144 + 16 * hh;
                S[q] = S[q] * egl;
#pragma unroll
                for (int s = 0; s < 4; ++s) S[q] = __builtin_amdgcn_mfma_f32_32x32x16_bf16(*(const LAS bf16x8*)(kp + 32 * s), vf[s], S[q], 0, 0, 0);
            }
        }
        __syncthreads();
#pragma unroll
        for (int q = 0; q < 2; ++q)
#pragma unroll
            for (int g = 0; g < 4; ++g) { u32x2 o; o.x = pk2(S[q][4 * g], S[q][4 * g + 1]); o.y = pk2(S[q][4 * g + 2], S[q][4 * g + 3]); *(LAS u32x2*)(lds + SL_ST + (32 * vb + r32) * 272 + (32 * (2 * kb2 + q) + 8 * g + 4 * hh) * 2) = o; }
        {
            const int t = (n == 0) ? ni - 48 : NMETA + 64 * (n - 1) + ni;
            float ov[16]; float ss = 0.f;
#pragma unroll
            for (int e4 = 0; e4 < 4; ++e4) { const f32x4 v4 = *(const LAS f32x4*)(lds + SL_O + (ni * 132 + 16 * npart + 4 * e4) * 4); ov[4 * e4] = v4.x; ov[4 * e4 + 1] = v4.y; ov[4 * e4 + 2] = v4.z; ov[4 * e4 + 3] = v4.w; ss += v4.x * v4.x + v4.y * v4.y + v4.z * v4.z + v4.w * v4.w; }
            ss = sum8_dpp(ss);
            if (t >= 0 && (n > 0 || b == 0)) {
                const float rms = rsqrtf(ss * (1.f / 128.f) + 1e-6f);
                unsigned po[8];
#pragma unroll
                for (int e = 0; e < 8; ++e) {
                    const unsigned zz = e < 4 ? cZ0[e] : cZ1[e - 4];
                    po[e] = pk2(ov[2 * e] * rms * bf2f(zz & 0xffff), ov[2 * e + 1] * rms * bf2f(zz >> 16));
                }
                bf16_t* mp = MIX + (size_t)tok_row(b, t) * D + h * 128 + 16 * npart;
                *(u32x4*)mp = (u32x4){po[0], po[1], po[2], po[3]}; *(u32x4*)(mp + 8) = (u32x4){po[4], po[5], po[6], po[7]};
            }
        }
        if (more) { lwrite(nx); cU0 = nx.u[0]; cU1 = nx.u[1]; cZ0 = zn0; cZ1 = zn1; cG = nx.g; }
        __syncthreads();
    };
    for (int n = 0; n < 33; ++n) chunk(n, s0, s0);
}

__device__ __forceinline__ int queue_pop(unsigned* ctr, LAS char* lds) {
    LAS int* slot = (LAS int*)(lds + LDS_BYTES - 16);
    __syncthreads();
    if (threadIdx.x == 0) *slot = (int)atomicAdd(ctr, 1u);
    __syncthreads();
    return *slot;
}


__device__ __forceinline__ int wave_sum_dpp(int v) {
    v += __builtin_amdgcn_mov_dpp(v, 0xB1, 0xf, 0xf, false);
    v += __builtin_amdgcn_mov_dpp(v, 0x4E, 0xf, 0xf, false);
    v += __builtin_amdgcn_mov_dpp(v, 0x141, 0xf, 0xf, false);
    v += __builtin_amdgcn_mov_dpp(v, 0x140, 0xf, 0xf, false);
    return __builtin_amdgcn_readlane(v, 0) + __builtin_amdgcn_readlane(v, 16) + __builtin_amdgcn_readlane(v, 32) + __builtin_amdgcn_readlane(v, 48);
}

__device__ __forceinline__ unsigned pk_gt1(unsigned keys, unsigned cm1, unsigned one2) {
    unsigned t, r;
    asm("v_pk_sub_u16 %0, %1, %2 clamp" : "=v"(t) : "v"(keys), "v"(cm1));
    asm("v_pk_min_u16 %0, %1, %2" : "=v"(r) : "v"(t), "v"(one2));
    return r;
}
__device__ __forceinline__ unsigned pk_add(unsigned a, unsigned b) { unsigned r; asm("v_pk_add_u16 %0, %1, %2" : "=v"(r) : "v"(a), "v"(b)); return r; }
__device__ __forceinline__ unsigned pk_count17(const unsigned (&pk)[17], unsigned cm1, unsigned one2) {
    unsigned t[17];
#pragma unroll
    for (int k = 0; k < 17; ++k) t[k] = pk_gt1(pk[k], cm1, one2);
#pragma unroll
    for (int k = 0; k < 8; ++k) t[k] = pk_add(t[k], t[k + 8]);
#pragma unroll
    for (int k = 0; k < 4; ++k) t[k] = pk_add(t[k], t[k + 4]);
    t[0] = pk_add(pk_add(t[0], t[1]), pk_add(t[2], t[3]));
    return pk_add(t[0], t[16]);
}
__device__ __forceinline__ unsigned pk_pair_sum(unsigned na, unsigned nb) {
    return pk_add(__builtin_amdgcn_perm(nb, na, 0x05040100u), __builtin_amdgcn_perm(nb, na, 0x07060302u));
}
constexpr int CW_IDXF = 8192;
constexpr int IDX_SPLIT = 128;
constexpr int SC_PITCH = 2084;
__device__ __forceinline__ void idx_unit(const Params& p, int u, LAS char* lds) {
    const int tid = otid(), lane = tid & 63, wid = tid >> 6, r32 = lane & 31, hh = lane >> 5;
    const int b = u & 7, qb = 127 - (u >> 3);
    const int t0 = NMETA + 16 * qb, NK = t0 + 16, nkb = (NK + 31) >> 5;
    const bf16_t* PROJ = (const bf16_t*)(p.ws + WS_PROJ); const bf16_t* IK = (const bf16_t*)(p.ws + WS_IK); const float* PX = (const float*)(p.ws + WS_PX);
    unsigned* MASK = (unsigned*)(p.ws + WS_MASK);
    LAS float* SC = (LAS float*)lds;
    {
        const int qrow = b * SEQ + 16 * qb + (r32 & 15), hpar = r32 >> 4;
        bf16x8 qf[4][4]; float wq[4];
#pragma unroll
        for (int hp = 0; hp < 4; ++hp) {
#pragma unroll
            for (int s = 0; s < 4; ++s) qf[hp][s] = *(const bf16x8*)(PROJ + (size_t)qrow * 4096 + 3584 + (2 * hp + hpar) * 64 + 16 * s + 8 * hh);
            wq[hp] = PX[(size_t)qrow * 16 + 8 + 2 * hp + hpar] * (0.125f * 0.35355339059327373f);
        }
        bf16x8 kf[4], kn[4], kn2[4];
        auto kload = [&](bf16x8 (&dst)[4], int kb_) {
            int tk = 32 * kb_ + r32; tk = tk < LT ? tk : LT - 1;
            const bf16_t* kp = IK + (size_t)tok_row(b, tk) * 64 + 8 * hh;
#pragma unroll
            for (int s = 0; s < 4; ++s) dst[s] = *(const bf16x8*)(kp + 16 * s);
        };
        kload(kn, wid); kload(kn2, wid + 8);
        for (int kb = wid; kb < nkb; kb += 8) {
#pragma unroll
            for (int s = 0; s < 4; ++s) { kf[s] = kn[s]; kn[s] = kn2[s]; }
            kload(kn2, kb + 16);
            f32x16 sc;
#pragma unroll
            for (int r = 0; r < 16; ++r) sc[r] = 0.f;
#pragma unroll
            for (int hp = 0; hp < 4; ++hp) {
                f32x16 d;
#pragma unroll
                for (int r = 0; r < 16; ++r) d[r] = 0.f;
#pragma unroll
                for (int s = 0; s < 4; ++s) d = __builtin_amdgcn_mfma_f32_32x32x16_bf16(kf[s], qf[hp][s], d, 0, 0, 0);
#pragma unroll
                for (int r = 0; r < 16; ++r) sc[r] += wq[hp] * fmaxf(d[r], 0.f);
            }
#pragma unroll
            for (int r = 0; r < 16; ++r) sc[r] += __shfl_xor(sc[r], 16);
            if (hpar == 0) {
#pragma unroll
                for (int g = 0; g < 4; ++g) *(LAS f32x4*)(SC + (r32 & 15) * SC_PITCH + 32 * kb + 8 * g + 4 * hh) = (f32x4){sc[4 * g], sc[4 * g + 1], sc[4 * g + 2], sc[4 * g + 3]};
            }
        }
    }
    __syncthreads();
    {
        const int qa = 2 * wid, tqa = t0 + qa, tqb = tqa + 1;
        unsigned ua[33], ub[33];
#pragma unroll
        for (int j = 0; j < 33; ++j) {
            const int key = 64 * j + lane;
            float fa = (key <= tqa) ? SC[qa * SC_PITCH + key] : 0.f, fb = (key <= tqb) ? SC[(qa + 1) * SC_PITCH + key] : 0.f;
            fa += 0.f; fb += 0.f;
            const unsigned ba = __builtin_bit_cast(unsigned, fa), bb = __builtin_bit_cast(unsigned, fb);
            ua[j] = (key <= tqa) ? (ba ^ ((ba >> 31) ? 0xffffffffu : 0x80000000u)) : 0u;
            ub[j] = (key <= tqb) ? (bb ^ ((bb >> 31) ? 0xffffffffu : 0x80000000u)) : 0u;
        }
        unsigned one2 = 0x00010001u; asm volatile("" : "+v"(one2));
        unsigned pa[17], pb[17];
#pragma unroll
        for (int k = 0; k < 17; ++k) {
            pa[k] = (ua[2 * k] >> 16) | (k < 16 ? (ua[2 * k + 1] & 0xffff0000u) : 0u);
            pb[k] = (ub[2 * k] >> 16) | (k < 16 ? (ub[2 * k + 1] & 0xffff0000u) : 0u);
        }
        unsigned thra = 0u, thrb = 0u;
        bool acta = tqa + 1 > 256, actb = tqb + 1 > 256;
        bool p2a = acta, p2b = actb;
        for (int bit = 15; bit >= 0 && (acta || actb); --bit) {
            const unsigned ca = (thra | (1u << bit)) - 1u, cb = (thrb | (1u << bit)) - 1u;
            const unsigned ca2 = ca * 0x00010001u, cb2 = cb * 0x00010001u;
            const unsigned na = pk_count17(pa, ca2, one2), nb = pk_count17(pb, cb2, one2);
            const int tt = wave_sum_dpp((int)pk_pair_sum(na, nb)), ta = tt & 0xffff, tb = (int)((unsigned)tt >> 16);
            if (acta) { if (ta >= 256) thra = ca + 1u; if (ta == 256) { acta = false; p2a = false; } }
            if (actb) { if (tb >= 256) thrb = cb + 1u; if (tb == 256) { actb = false; p2b = false; } }
        }
        int wanta = 0, wantb = 0;
        {
            const unsigned ha = thra * 0x00010001u, hb = thrb * 0x00010001u;
            const unsigned ga = pk_count17(pa, ha, one2), gb = pk_count17(pb, hb, one2);
            const int gg = wave_sum_dpp((int)pk_pair_sum(ga, gb));
            wanta = 256 - (gg & 0xffff); wantb = 256 - (int)((unsigned)gg >> 16);
#pragma unroll
            for (int k = 0; k < 17; ++k) {
                const unsigned a0 = ua[2 * k], a1 = k < 16 ? ua[2 * k + 1] : 0u, b0 = ub[2 * k], b1 = k < 16 ? ub[2 * k + 1] : 0u;
                pa[k] = ((a0 >> 16) == thra ? (a0 & 0xffffu) : 0u) | ((a1 >> 16) == thra ? (a1 << 16) : 0u);
                pb[k] = ((b0 >> 16) == thrb ? (b0 & 0xffffu) : 0u) | ((b1 >> 16) == thrb ? (b1 << 16) : 0u);
            }
        }
        unsigned lowa = 0u, lowb = 0u;
        int c2a = -1, c2b = -1;
        acta = p2a; actb = p2b;
        for (int bit = 15; bit >= 0 && (acta || actb); --bit) {
            const unsigned ca = (lowa | (1u << bit)) - 1u, cb = (lowb | (1u << bit)) - 1u;
            const unsigned ca2 = ca * 0x00010001u, cb2 = cb * 0x00010001u;
            const unsigned na = pk_count17(pa, ca2, one2), nb = pk_count17(pb, cb2, one2);
            const int tt = wave_sum_dpp((int)pk_pair_sum(na, nb)), ta = tt & 0xffff, tb = (int)((unsigned)tt >> 16);
            if (acta) { if (ta >= wanta) { lowa = ca + 1u; c2a = ta; } if (ta == wanta) acta = false; }
            if (actb) { if (tb >= wantb) { lowb = cb + 1u; c2b = tb; } if (tb == wantb) actb = false; }
        }
        thra = (thra << 16) | lowa; thrb = (thrb << 16) | lowb;
        const bool exa = !p2a || c2a == wanta, exb = !p2b || c2b == wantb;
#pragma unroll
        for (int qq = 0; qq < 2; ++qq) {
            const int n = (qq ? tqb : tqa) + 1; const unsigned thr = qq ? thrb : thra;
            unsigned* mrow = MASK + (size_t)(b * SEQ + 16 * qb + qa + qq) * MASKW;
            const bool simple = (n <= 256) || (qq ? exb : exa);
            int run = 0;
            unsigned wlo = 0u, whi = 0u;
            if (simple) {
                const unsigned tcmp = (n <= 256) ? 1u : thr;
#pragma unroll
                for (int j = 0; j < 33; ++j) {
                    const unsigned long long w = __ballot((qq ? ub[j] : ua[j]) >= tcmp);
                    if (lane == j) { wlo = (unsigned)w; whi = (unsigned)(w >> 32); }
                }
            } else {
                int cg = 0;
#pragma unroll
                for (int j = 0; j < 33; ++j) cg += ((qq ? ub[j] : ua[j]) > thr) ? 1 : 0;
                const int need = 256 - wave_sum_dpp(cg);
#pragma unroll
                for (int j = 0; j < 33; ++j) {
                    const unsigned uv = qq ? ub[j] : ua[j];
                    const bool eq = uv == thr;
                    const unsigned long long beq = __ballot(eq);
                    const int rank = run + (int)__builtin_amdgcn_mbcnt_hi((unsigned)(beq >> 32), __builtin_amdgcn_mbcnt_lo((unsigned)beq, 0u));
                    const bool take = (uv > thr) || (eq && rank < need);
                    const unsigned long long w = __ballot(take);
                    run += __popcll(beq);
                    if (lane == j) { wlo = (unsigned)w; whi = (unsigned)(w >> 32); }
                }
            }
            if (lane < 34) __hip_atomic_store((unsigned long long*)(mrow + 2 * lane), ((unsigned long long)whi << 32) | wlo, __ATOMIC_RELAXED, __HIP_MEMORY_SCOPE_AGENT);
        }
    }
}
__device__ __forceinline__ void meta_mask_unit(const Params& p) {
    unsigned* MASK = (unsigned*)(p.ws + WS_MASK) + (size_t)NMAIN * MASKW;
    for (int i = otid(); i < NMETA * MASKW; i += NTHREADS) { const int t = i / MASKW, w = i % MASKW; MASK[i] = w == 0 ? ((2u << t) - 1u) : 0u; }
}

constexpr int AL_VT = 9216, AL_STG = 21504;
__device__ __forceinline__ void attn_unit(const Params& p, int l_, int item, LAS char* lds) {
    const int tid = otid(), lane = tid & 63, wid = tid >> 6, r32 = lane & 31, hh = lane >> 5;
    const bool meta = item >= 512;
    const int qblk = meta ? 0 : 7 - (item >> 6), b = meta ? 0 : (item & 63) >> 3, h = meta ? item - 512 : item & 7;
    if (!meta && (127 - 16 * qblk) * 8 + b >= IDX_SPLIT) {
        if (tid == 0) {
            unsigned* f = (unsigned*)(p.ws + WS_CTL) + CW_IDXF + l_ * 64 + b * 8 + qblk;
            unsigned sp = 0u;
            while (__hip_atomic_load(f, __ATOMIC_RELAXED, __HIP_MEMORY_SCOPE_AGENT) < 16u && ++sp < (1u << 22)) __builtin_amdgcn_s_sleep(2);
            __builtin_amdgcn_fence(__ATOMIC_ACQUIRE, "agent");
            asm volatile("s_waitcnt vmcnt(0)" ::: "memory");
        }
        __syncthreads();
    }
    const int qi = 32 * wid + r32;
    const bool qvalid = !meta || qi < NMETA;
    const int qrow = meta ? NMAIN + (qvalid ? qi : NMETA - 1) : b * SEQ + 256 * qblk + qi;
    const int ntiles = meta ? 1 : 4 * qblk + 5;
    const int wt_last = meta ? 0 : (NMETA + 256 * qblk + 32 * wid + 31) >> 6;
    const bf16_t* PROJ = (const bf16_t*)(p.ws + WS_PROJ);
    const unsigned* mrow = (const unsigned*)(p.ws + WS_MASK) + (size_t)qrow * MASKW;
    bf16x8 qf[4];
#pragma unroll
    for (int s = 0; s < 4; ++s) qf[s] = *(const bf16x8*)(PROJ + (size_t)qrow * 4096 + 2048 + h * 64 + 16 * s + 8 * hh);
    float m = -1e30f, l = 0.f; f32x16 o[2];
#pragma unroll
    for (int r = 0; r < 16; ++r) { o[0][r] = 0.f; o[1][r] = 0.f; }
    const int skey = tid >> 3, sch = tid & 7;
    u32x4 kreg, vreg;
    auto gload = [&](int j) {
        int tk = 64 * j + skey; tk = tk < LT ? tk : LT - 1;
        const bf16_t* rp = PROJ + (size_t)tok_row(b, tk) * 4096 + h * 64 + 8 * sch;
        kreg = *(const u32x4*)(rp + 2560); vreg = *(const u32x4*)(rp + 3072);
    };
    auto lwrite = [&](int st) {
        LAS char* sb = lds + st * AL_STG;
        *(LAS u32x4*)(sb + skey * 144 + sch * 16) = kreg;
        *(LAS u32x4*)(sb + AL_VT + skey * 192 + sch * 16) = vreg;
    };
    gload(0); lwrite(0);
    u32x2 mwn = *(const u32x2*)(mrow);
    __syncthreads();
    for (int j = 0; j < ntiles; ++j) {
        const bool more = j + 1 < ntiles;
        if (more) gload(j + 1);
        const u32x2 mw = mwn;
        if (more) mwn = *(const u32x2*)(mrow + 2 * (j + 1));
        if (j <= wt_last) {
            const unsigned mw0 = qvalid ? mw.x : 0u, mw1 = qvalid ? mw.y : 0u;
            LAS char* sb = lds + (j & 1) * AL_STG;
            f32x16 p0, p1;
#pragma unroll
            for (int r = 0; r < 16; ++r) { p0[r] = 0.f; p1[r] = 0.f; }
#pragma unroll
            for (int s = 0; s < 4; ++s) {
                const bf16x8 k0 = *(const LAS bf16x8*)(sb + r32 * 144 + 32 * s + 16 * hh), k1 = *(const LAS bf16x8*)(sb + (32 + r32) * 144 + 32 * s + 16 * hh);
                p0 = __builtin_amdgcn_mfma_f32_32x32x16_bf16(k0, qf[s], p0, 0, 0, 0); p1 = __builtin_amdgcn_mfma_f32_32x32x16_bf16(k1, qf[s], p1, 0, 0, 0);
            }
            float tmax = -INFINITY;
#pragma unroll
            for (int r = 0; r < 16; ++r) {
                const int bit = (r & 3) + 8 * (r >> 2) + 4 * hh;
                p0[r] = ((mw0 >> bit) & 1u) ? p0[r] : -INFINITY; p1[r] = ((mw1 >> bit) & 1u) ? p1[r] : -INFINITY;
                tmax = fmaxf(tmax, fmaxf(p0[r], p1[r]));
            }
            { const unsigned tb_ = __builtin_bit_cast(unsigned, tmax); auto rr = __builtin_amdgcn_permlane32_swap(tb_, tb_, false, false); tmax = fmaxf(__builtin_bit_cast(float, (unsigned)rr[0]), __builtin_bit_cast(float, (unsigned)rr[1])); }
            const float mnew = fmaxf(m, tmax), alpha = __builtin_amdgcn_exp2f(m - mnew);
            float rs = 0.f;
#pragma unroll
            for (int r = 0; r < 16; ++r) { p0[r] = __builtin_amdgcn_exp2f(p0[r] - mnew); p1[r] = __builtin_amdgcn_exp2f(p1[r] - mnew); rs += p0[r] + p1[r]; }
            { const unsigned rb_ = __builtin_bit_cast(unsigned, rs); auto rr = __builtin_amdgcn_permlane32_swap(rb_, rb_, false, false); rs = __builtin_bit_cast(float, (unsigned)rr[0]) + __builtin_bit_cast(float, (unsigned)rr[1]); }
            l = l * alpha + rs; m = mnew;
            o[0] = o[0] * alpha; o[1] = o[1] * alpha;
#pragma unroll
            for (int blk = 0; blk < 2; ++blk)
#pragma unroll
                for (int s = 0; s < 2; ++s) {
                    u32x4 pw;
#pragma unroll
                    for (int e = 0; e < 4; ++e) pw[e] = blk ? pk2(p1[8 * s + 2 * e], p1[8 * s + 2 * e + 1]) : pk2(p0[8 * s + 2 * e], p0[8 * s + 2 * e + 1]);
                    const bf16x8 pf = __builtin_bit_cast(bf16x8, pw);
#pragma unroll
                    for (int db = 0; db < 2; ++db) {
                        LAS char* vp = sb + AL_VT + (32 * blk + 16 * s + 4 * hh + ((lane & 15) >> 2)) * 192 + (32 * db + (lane & 16) + 4 * (lane & 3)) * 2;
                        typedef short v4i16_t __attribute__((ext_vector_type(4)));
                        const v4i16_t va = __builtin_amdgcn_ds_read_tr16_b64_v4i16((LAS v4i16_t*)vp), vb = __builtin_amdgcn_ds_read_tr16_b64_v4i16((LAS v4i16_t*)(vp + 8 * 192));
                        const bf16x8 vf = (bf16x8){va[0], va[1], va[2], va[3], vb[0], vb[1], vb[2], vb[3]};
                        o[db] = __builtin_amdgcn_mfma_f32_32x32x16_bf16(vf, pf, o[db], 0, 0, 0);
                    }
                }
        }
        if (more) lwrite((j + 1) & 1);
        __syncthreads();
    }
    if (qvalid) {
        const float inv = 1.f / l;
        bf16_t* dst = (bf16_t*)(p.ws + WS_BF) + (size_t)qrow * D + 512 + h * 64 + 4 * hh;
#pragma unroll
        for (int db = 0; db < 2; ++db)
#pragma unroll
            for (int g = 0; g < 4; ++g) { u32x2 ov; ov.x = pk2(o[db][4 * g] * inv, o[db][4 * g + 1] * inv); ov.y = pk2(o[db][4 * g + 2] * inv, o[db][4 * g + 3] * inv); *(u32x2*)(dst + 32 * db + 8 * g) = ov; }
    }
}

__device__ __forceinline__ void phaseB(const Params& p, int l, bool second, int ph, LAS char* lds) {
    unsigned* ctr = (unsigned*)(p.ws + WS_CTL) + 16 + ph;
    if (second) { if (blockIdx.x < 32) dn_scan(p, l, blockIdx.x >> 2, blockIdx.x & 3, lds); }
    else if (blockIdx.x == gridDim.x - 1) meta_mask_unit(p);
    const int u0 = second ? IDX_SPLIT : 0, n_idx = second ? 1024 - IDX_SPLIT : IDX_SPLIT, n_tot = n_idx + (second ? 520 : 1056);
    for (;;) {
        const int it = queue_pop(ctr, lds);
        if (it >= n_tot) break;
        if (it < n_idx) {
            const int u = it + u0;
            idx_unit(p, u, lds);
            asm volatile("s_waitcnt vmcnt(0)" ::: "memory");
            __syncthreads();
            if (threadIdx.x == 0) __hip_atomic_fetch_add((unsigned*)(p.ws + WS_CTL) + CW_IDXF + l * 64 + (u & 7) * 8 + ((127 - (u >> 3)) >> 4), 1u, __ATOMIC_RELAXED, __HIP_MEMORY_SCOPE_AGENT);
        } else if (second) attn_unit(p, l, it - n_idx, lds);
        else dn_intra_item(p, l, it - n_idx, lds);
    }
}

constexpr int CW_CNT = 256;

__device__ __forceinline__ void phaseD(const Params& p, int l, int nrows, LAS char* lds) {
    const int tid = otid(), lane = tid & 63, wid = tid >> 6;
    const int gw = blockIdx.x * 8 + wid, NGW = gridDim.x * 8;
    {
        LAS char* scr = lds + wid * 9216;
        const float* w1 = inptr(p, I_W1) + (size_t)l * NEXP * D * DEXP; const float* w3 = inptr(p, I_W3) + (size_t)l * NEXP * D * DEXP; const float* w2 = inptr(p, I_W2) + (size_t)l * NEXP * DEXP * D;
        for (int it = gw; it < NEXP * 192; it += NGW) {
            const int e = it / 192; int r = it % 192;
            if (r < 128) {
                const int isb = r >> 6, kb = (r >> 2) & 15, nb = r & 3;
                auto orow = [&](int f) -> int { return 64 * (f >> 5) + 32 * isb + (f & 31); };
                transpose_tile64((isb ? w3 : w1) + (size_t)e * D * DEXP, DEXP, kb * 64, nb * 64, (bf16_t*)(p.ws + WS_W13T) + (size_t)e * 512 * D, D, orow, scr, lane);
            } else {
                r -= 128; const int kb = r >> 4, nb = r & 15;
                auto orow = [&](int n) -> int { return n; };
                transpose_tile64(w2 + (size_t)e * DEXP * D, D, kb * 64, nb * 64, (bf16_t*)(p.ws + WS_W2T) + (size_t)e * D * DEXP, DEXP, orow, scr, lane);
            }
        }
    }
    __syncthreads();
    LAS float* Wl = (LAS float*)lds;
    LAS unsigned* lcnt = (LAS unsigned*)(lds + 147456);
    LAS unsigned* lbase = lcnt + 32;
    LAS unsigned* lent = lcnt + 64;
    {
        const f32x4* rw = (const f32x4*)(p.ws + WS_RW + (size_t)l * D * 36 * 4);
        for (int idx = tid; idx < D * 9; idx += NTHREADS) *(LAS f32x4*)(lds + idx * 16) = rw[idx];
        if (tid < 32) lcnt[tid] = 0u;
        for (int idx = tid; idx < 8 * 10 * 2; idx += NTHREADS) lent[idx * 4] = 0xffffffffu;
    }
    __syncthreads();
    const float* g = inptr(p, I_LN1G) + l * D; const float* bb = inptr(p, I_LN1B) + l * D;
    const float* bg = inptr(p, I_BGRP) + l * 4; const float* br = inptr(p, I_BRTR) + l * 32;
    bf16_t* Hb = (bf16_t*)(p.ws + WS_BF);
    unsigned* cnt = (unsigned*)(p.ws + WS_CTL) + CW_CNT + l * 64;
    unsigned* list = (unsigned*)(p.ws + WS_LIST); float* listg = (float*)(p.ws + WS_LISTG);
    int kr = 0;
    u32x2 vnx[4];
    if (gw < nrows) {
#pragma unroll
        for (int j = 0; j < 4; ++j) vnx[j] = *(const u32x2*)(y1_row(p, gw) + (lane + 64 * j) * 4);
    }
    for (int row = gw; row < nrows; row += NGW, ++kr) {
        f32x4 v[4]; float s = 0.f;
#pragma unroll
        for (int j = 0; j < 4; ++j) { v[j] = bf4(vnx[j]); s += (v[j].x + v[j].y) + (v[j].z + v[j].w); }
        if (row + NGW < nrows) {
            const bf16_t* np_ = y1_row(p, row + NGW);
#pragma unroll
            for (int j = 0; j < 4; ++j) vnx[j] = *(const u32x2*)(np_ + (lane + 64 * j) * 4);
        }
        const float mean = wave_sum(s) * (1.f / D); float s2 = 0.f;
#pragma unroll
        for (int j = 0; j < 4; ++j) { v[j] = v[j] - mean; s2 += (v[j].x * v[j].x + v[j].y * v[j].y) + (v[j].z * v[j].z + v[j].w * v[j].w); }
        const float rstd = 1.f / sqrtf(wave_sum(s2) * (1.f / D) + 1e-5f);
        f32x4 lg = (f32x4){0.f, 0.f, 0.f, 0.f};
#pragma unroll
        for (int j = 0; j < 4; ++j) {
            const f32x4 gg = *(const f32x4*)(g + (lane + 64 * j) * 4), bv = *(const f32x4*)(bb + (lane + 64 * j) * 4);
            const f32x4 o = v[j] * rstd * gg + bv; v[j] = o;
            u32x2 ob; ob.x = pk2(o.x, o.y); ob.y = pk2(o.z, o.w);
            *(u32x2*)(Hb + (size_t)row * D + (lane + 64 * j) * 4) = ob;
#pragma unroll
            for (int i = 0; i < 4; ++i) lg += *(const LAS f32x4*)(Wl + ((j * 4 + i) * 64 + lane) * 36) * o[i];
        }
        float l0 = wave_sum(lg.x) + bg[0], l1 = wave_sum(lg.y) + bg[1], l2 = wave_sum(lg.z) + bg[2], l3 = wave_sum(lg.w) + bg[3];
        int gsel = 0; float gm = l0;
        if (l1 > gm) { gm = l1; gsel = 1; }
        if (l2 > gm) { gm = l2; gsel = 2; }
        if (l3 > gm) { gm = l3; gsel = 3; }
        const float gprob = 1.f / (__expf(l0 - gm) + __expf(l1 - gm) + __expf(l2 - gm) + __expf(l3 - gm));
        gsel = __builtin_amdgcn_readfirstlane(gsel);
        f32x4 ea = (f32x4){0.f, 0.f, 0.f, 0.f}, eb = (f32x4){0.f, 0.f, 0.f, 0.f};
#pragma unroll
        for (int j = 0; j < 4; ++j)
#pragma unroll
            for (int i = 0; i < 4; ++i) {
                const LAS float* wp = Wl + ((j * 4 + i) * 64 + lane) * 36 + 4 + 8 * gsel;
                ea += *(const LAS f32x4*)(wp) * v[j][i]; eb += *(const LAS f32x4*)(wp + 4) * v[j][i];
            }
        float el[8];
        el[0] = wave_sum(ea.x); el[1] = wave_sum(ea.y); el[2] = wave_sum(ea.z); el[3] = wave_sum(ea.w);
        el[4] = wave_sum(eb.x); el[5] = wave_sum(eb.y); el[6] = wave_sum(eb.z); el[7] = wave_sum(eb.w);
#pragma unroll
        for (int i = 0; i < 8; ++i) el[i] += br[8 * gsel + i];
        int i0 = 0; float m0 = el[0];
#pragma unroll
        for (int i = 1; i < 8; ++i) if (el[i] > m0) { m0 = el[i]; i0 = i; }
        int i1 = -1; float m1 = -INFINITY;
#pragma unroll
        for (int i = 0; i < 8; ++i) if (i != i0 && el[i] > m1) { m1 = el[i]; i1 = i; }
        const float x1 = __expf(m1 - m0);
        const float gate0 = gprob / (1.f + x1), gate1 = gprob * x1 / (1.f + x1);
        if (lane == 0) {
            const int e0 = gsel * 8 + i0, e1 = gsel * 8 + i1;
            const unsigned r0 = __hip_atomic_fetch_add(lcnt + e0, 1u, __ATOMIC_RELAXED, __HIP_MEMORY_SCOPE_WORKGROUP), r1 = __hip_atomic_fetch_add(lcnt + e1, 1u, __ATOMIC_RELAXED, __HIP_MEMORY_SCOPE_WORKGROUP);
            LAS unsigned* en = lent + ((wid * 10 + kr) * 2) * 4;
            en[0] = (unsigned)e0; en[1] = r0; en[2] = (unsigned)row * 2u; en[3] = __builtin_bit_cast(unsigned, gate0);
            en[4] = (unsigned)e1; en[5] = r1; en[6] = (unsigned)row * 2u + 1u; en[7] = __builtin_bit_cast(unsigned, gate1);
        }
    }
    __syncthreads();
    if (tid < 32) { const unsigned c = lcnt[tid]; lbase[tid] = c ? atomicAdd(cnt + tid, c) : 0u; }
    __syncthreads();
    if (tid < 8 * 10 * 2) {
        const unsigned e = lent[tid * 4];
        if (e != 0xffffffffu) { const unsigned pos = lbase[e] + lent[tid * 4 + 1]; list[e * LIST_CAP + pos] = lent[tid * 4 + 2]; listg[e * LIST_CAP + pos] = __builtin_bit_cast(float, lent[tid * 4 + 3]); }
    }
}

constexpr int MOE_TAB = 131072;
__device__ __forceinline__ void moe_build_table(const unsigned* cnt, LAS int* tab) {
    const int tid = otid();
    __syncthreads();
    if (tid < 32) tab[tid] = (int)cnt[tid];
    __syncthreads();
    if (tid == 0) { int acc = 0; for (int e = 0; e < NEXP; ++e) { tab[32 + e] = acc; acc += (tab[e] + 255) >> 8; } tab[64] = acc; }
    __syncthreads();
}
template <int NT>
__device__ __forceinline__ bool moe_unit(const LAS int* tab, int u, int& e, int& mt, int& nt, int& c, int& hb) {
    const int gt = u / NT; nt = u % NT;
    if (gt >= tab[64]) return false;
    int lo = 0;
#pragma unroll
    for (int s = 16; s > 0; s >>= 1) if (tab[32 + lo + s] <= gt) lo += s;
    e = lo; mt = gt - tab[32 + e]; c = tab[e]; hb = tab[32 + e] * 256;
    return true;
}
__device__ __forceinline__ void phaseE1(const Params& p, int l, LAS char* lds) {
    const int hh = (otid() & 63) >> 5;
    const unsigned* cnt = (const unsigned*)(p.ws + WS_CTL) + CW_CNT + l * 64;
    const unsigned* list = (const unsigned*)(p.ws + WS_LIST); const float* listg = (const float*)(p.ws + WS_LISTG);
    const bf16_t* H1b = (const bf16_t*)(p.ws + WS_BF); bf16_t* HID = (bf16_t*)(p.ws + WS_HID);
    LAS int* tab = (LAS int*)(lds + MOE_TAB);
    moe_build_table(cnt, tab);
    for (int u = blockIdx.x;; u += gridDim.x) {
        int e, mt, nt, c, hb;
        if (!moe_unit<4>(tab, u, e, mt, nt, c, hb)) break;
        auto arow = [&](int r) -> const bf16_t* { const int idx = mt * 256 + r; const unsigned ent = list[e * LIST_CAP + (idx < c ? idx : 0)]; return H1b + (size_t)(ent >> 1) * D; };
        auto epi = [&](int mloc, int nloc0, const f32x16& c0, const f32x16& c1) {
            const int idx = mt * 256 + mloc;
            if (idx < c) {
                const float gt = listg[e * LIST_CAP + idx];
                bf16_t* dst = HID + (size_t)(hb + idx) * DEXP + (nt * 2 + (nloc0 >> 6)) * 32 + 4 * hh;
#pragma unroll
                for (int g = 0; g < 4; ++g) {
                    float h[4];
#pragma unroll
                    for (int j = 0; j < 4; ++j) { const float a = c0[4 * g + j], b = c1[4 * g + j]; h[j] = silu_f(a) * b * gt; }
                    u32x2 o; o.x = pk2(h[0], h[1]); o.y = pk2(h[2], h[3]);
                    *(u32x2*)(dst + 8 * g) = o;
                }
            }
        };
        gemm_tile<2>(lds, arow, (const bf16_t*)(p.ws + WS_W13T) + ((size_t)e * 512 + nt * 128) * D, D, epi);
    }
}

#define XB_TMO      128
#define XB_XCNT(j)  (256  + 64 * (j))
#define XB_XSUB(j)  (1280 + 64 * (j))
#define XB_XGEN(j)  (2304 + 64 * (j))
#define XB_TOP      3328
#define XB_TOPGEN   3392
#define XCD_BAR_WORDS 3456
#define XB_SPIN_CAP (1u << 18)
constexpr int CW_BAR = 4096;
__device__ __forceinline__ unsigned xb_ld(unsigned* p)              { return __hip_atomic_load(p, __ATOMIC_RELAXED, __HIP_MEMORY_SCOPE_AGENT); }
__device__ __forceinline__ unsigned xb_add(unsigned* p, unsigned v) { return __hip_atomic_fetch_add(p, v, __ATOMIC_RELAXED, __HIP_MEMORY_SCOPE_AGENT); }
__device__ __forceinline__ unsigned xb_xcc_id() { return (unsigned)__builtin_amdgcn_s_getreg((3 << 11) | 20) & 0xFu; }
#define XB_SPIN(cond, bar) do { unsigned _sp = 0; while (cond) { __builtin_amdgcn_s_sleep(1); \
    if ((++_sp & 255u) == 0u) { if (xb_ld(&(bar)[XB_TMO])) break; if (_sp > XB_SPIN_CAP) { atomicAdd(&(bar)[XB_TMO], 1u); break; } } } } while (0)
struct XcdBarrier { unsigned* bar; unsigned x; volatile LAS unsigned* st; };
__device__ __forceinline__ XcdBarrier xcd_barrier_post(unsigned* bar, volatile LAS unsigned* st) {
    XcdBarrier b; b.bar = bar; b.x = xb_xcc_id(); b.st = st;
    if (threadIdx.x == 0) (void)xb_add(&bar[XB_XCNT(b.x)], 1u);
    return b;
}
__device__ __forceinline__ void xcd_barrier_complete(unsigned* bar, unsigned x, unsigned& nloc, unsigned& nx) {
    const unsigned G = gridDim.x * gridDim.y * gridDim.z;
    unsigned sum, cnt, mine, sp = 0u;
    for (;;) {
        sum = 0u; cnt = 0u; mine = 0u;
#pragma unroll
        for (unsigned j = 0; j < 16; ++j) { const unsigned c = xb_ld(&bar[XB_XCNT(j)]); sum += c; cnt += (c > 0u) ? 1u : 0u; mine = (j == x) ? c : mine; }
        if (sum == G) break;
        __builtin_amdgcn_s_sleep(1);
        if ((++sp & 255u) == 0u) { if (xb_ld(&bar[XB_TMO])) break; if (sp > XB_SPIN_CAP) { atomicAdd(&bar[XB_TMO], 1u); break; } }
    }
    nloc = mine > 0u ? mine : 1u; nx = cnt > 0u ? cnt : 1u;
}
__device__ __forceinline__ void xcd_barrier(const XcdBarrier& b) {
    asm volatile("s_waitcnt vmcnt(0)" ::: "memory");
    __syncthreads();
    if (threadIdx.x == 0) {
        unsigned* bar = b.bar;
        __builtin_amdgcn_s_waitcnt(0);
        unsigned nloc = b.st[0], nx = b.st[1];
        if (nloc == 0u) { xcd_barrier_complete(bar, b.x, nloc, nx); b.st[0] = nloc; b.st[1] = nx; }
        const unsigned old = xb_add(&bar[XB_XSUB(b.x)], 1u);
        const unsigned gen = old / nloc;
        if (old + 1u == (gen + 1u) * nloc) {
            __builtin_amdgcn_fence(__ATOMIC_RELEASE, "agent");
            asm volatile("s_waitcnt vmcnt(0)" ::: "memory");
            const unsigned og = xb_add(&bar[XB_TOP], 1u);
            const unsigned tg = og / nx;
            if (og + 1u == (tg + 1u) * nx) xb_add(&bar[XB_TOPGEN], 1u);
            else XB_SPIN(xb_ld(&bar[XB_TOPGEN]) == tg, bar);
            __builtin_amdgcn_fence(__ATOMIC_ACQUIRE, "agent");
            xb_add(&bar[XB_XGEN(b.x)], 1u);
            asm volatile("s_waitcnt vmcnt(0)" ::: "memory");
        } else {
            XB_SPIN(xb_ld(&bar[XB_XGEN(b.x)]) == gen, bar);
            __builtin_amdgcn_fence(__ATOMIC_ACQUIRE, "agent");
            asm volatile("s_waitcnt vmcnt(0)" ::: "memory");
        }
    }
    __syncthreads();
}

constexpr int NPHASE = 17;
__global__ void __launch_bounds__(NTHREADS, 2) mega(Params p) {
    extern __shared__ __attribute__((aligned(16))) unsigned char lds_raw[];
    LAS char* lds = (LAS char*)lds_raw;
    volatile LAS unsigned* bst = (volatile LAS unsigned*)(lds + LDS_BYTES - 32);
    if (threadIdx.x < 2) bst[threadIdx.x] = 0u;
    __syncthreads();
    const XcdBarrier xbar = xcd_barrier_post((unsigned*)(p.ws + WS_CTL) + CW_BAR, bst);
    for (int ph = p.ph_lo; ph < p.ph_hi; ++ph) {
        { unsigned la = (unsigned)(uintptr_t)lds; asm volatile("" : "+v"(la)); lds = (LAS char*)(uintptr_t)la; }
        if (ph == 0) phase0(p, lds);
        else {
            const int l = (ph - 1) >> 3, s = (ph - 1) & 7;
            const int nrows = (l == 1) ? NMAIN : NROWS;
            if (s == 0) phaseA(p, l, lds);
            else if (s == 1 || s == 2) phaseB(p, l, s == 2, ph, lds);
            else if (s == 3 || s == 6) phaseCE(p, l, lds, s == 6 ? 1 : 0);
            else if (s == 4) phaseD(p, l, nrows, lds);
            else if (s == 5) phaseE1(p, l, lds);
            else if (s == 7) phaseG(p, l, nrows, l == 1);
        }
        if (ph + 1 < p.ph_hi) xcd_barrier(xbar);
    }
}

extern "C" void kernel_launch(void* const* d_in, const int* in_sizes, int n_in, void* d_out, int out_size, void* d_ws, size_t ws_size, hipStream_t stream) {
    static int grid = 0;
    if (grid == 0) {
        if (n_in != 19 || out_size != NMAIN * D || ws_size < WS_END) { fprintf(stderr, "kernel_launch: unexpected shapes (n_in %d out %d ws %zu)\n", n_in, out_size, ws_size); grid = -1; return; }
        int dev = 0, cus = 0, per_cu = 0;
        hipGetDevice(&dev);
        hipDeviceGetAttribute(&cus, hipDeviceAttributeMultiprocessorCount, dev);
        hipFuncSetAttribute((const void*)mega, hipFuncAttributeMaxDynamicSharedMemorySize, LDS_BYTES);
        hipOccupancyMaxActiveBlocksPerMultiprocessor(&per_cu, (const void*)mega, NTHREADS, LDS_BYTES);
        if (per_cu < 1) { fprintf(stderr, "kernel_launch: occupancy query says %d\n", per_cu); per_cu = 1; }
        (void)hipGetLastError();
        grid = cus;
    }
    if (grid < 0) return;
    hipMemsetAsync((char*)d_ws + WS_CTL, 0, CTL_BYTES, stream);
    Params p{};
    for (int i = 0; i < 19; ++i) p.in[i] = (const float*)d_in[i];
    p.out = (float*)d_out; p.ws = (unsigned char*)d_ws;
    for (int i = 0; i < 32; ++i) p.rope_inv[i] = (float)(1.0 / pow(10000.0, (double)(2 * i) / 64.0));
    p.ph_lo = 0; p.ph_hi = NPHASE;
    void* args[] = {&p};
    hipError_t e = hipLaunchCooperativeKernel((const void*)mega, dim3(grid), dim3(NTHREADS), args, LDS_BYTES, stream);
    if (e != hipSuccess) fprintf(stderr, "cooperative launch failed: %s (grid %d)\n", hipGetErrorString(e), grid);
}
```

```cpp
#include <hip/hip_runtime.h>
#include <hip/hip_cooperative_groups.h>
#include <cstdio>
#include <cstdint>
#include <cmath>
namespace cg = cooperative_groups;

#define LAS __attribute__((address_space(3)))
typedef unsigned short bf16_t;
typedef short bf16x8 __attribute__((ext_vector_type(8)));
typedef float f32x16 __attribute__((ext_vector_type(16)));
typedef float f32x4 __attribute__((ext_vector_type(4)));
typedef unsigned u32x4 __attribute__((ext_vector_type(4)));
typedef unsigned u32x2 __attribute__((ext_vector_type(2)));

constexpr int D = 1024, NB = 8, SEQ = 2048, NMETA = 16, LT = SEQ + NMETA;
constexpr int NMAIN = NB * SEQ;
constexpr int NROWS = NMAIN + NMETA;
constexpr int MROWS = NMAIN + 256;
constexpr int NPROJP = 4352;
constexpr int NEXP = 32, DEXP = 256;
constexpr float ALPHA = 1.4142135623730951f;
constexpr int NTHREADS = 512;
constexpr int LDS_BYTES = 155648;

constexpr size_t MiB = 1u << 20;
constexpr size_t WS_CTL = 0;
constexpr size_t CTL_BYTES = 65536;
constexpr size_t WS_ROPE = 1 * MiB;
constexpr size_t WS_METAR = 2 * MiB;
constexpr size_t WS_PX = 3 * MiB;
constexpr size_t WS_IK = 5 * MiB;
constexpr size_t WS_MASK = 8 * MiB;
constexpr size_t WS_LIST = 13 * MiB;
constexpr size_t WS_LISTG = 16 * MiB;
constexpr size_t WS_GL = 19 * MiB;
constexpr size_t WS_RW = 19 * MiB + 65536;
constexpr size_t WS_WIN = 20 * MiB;
constexpr size_t WS_WOUT = 37 * MiB;
constexpr size_t WS_BF = 42 * MiB;
constexpr size_t WS_PROJ = 75 * MiB;
constexpr size_t WS_EO = WS_PROJ;
constexpr size_t WS_HID = WS_PROJ + 66 * MiB;
constexpr size_t WS_X = 205 * MiB;
constexpr size_t WS_END = 280 * MiB;
constexpr int MASKW = 68;
constexpr int LIST_CAP = 16400;
constexpr size_t WS_W13T = WS_X;
constexpr size_t WS_W2T = WS_X + 32 * MiB;

struct Params {
    const float* in[19];
    float* out;
    unsigned char* ws;
    float rope_inv[32];
    int ph_lo, ph_hi;
};
enum { I_X = 0, I_META, I_WIN, I_CONV, I_ALOG, I_DTB, I_DNG, I_WOUT, I_LN1G, I_LN1B, I_WGRP, I_BGRP, I_WRTR, I_BRTR, I_W1, I_W3, I_W2, I_LN2G, I_LN2B };

typedef float f32x2_t __attribute__((ext_vector_type(2))); typedef __bf16 bf16x2_t __attribute__((ext_vector_type(2)));
__device__ __forceinline__ unsigned pk2(float lo, float hi) { const f32x2_t v = {lo, hi}; const bf16x2_t b = __builtin_convertvector(v, bf16x2_t); return __builtin_bit_cast(unsigned, b); }
__device__ __forceinline__ unsigned f2bf(float f) { return pk2(f, 0.f) & 0xffffu; }
__device__ __forceinline__ float bf2f(unsigned short b) { return __builtin_bit_cast(float, (unsigned)b << 16); }

__device__ __forceinline__ float sum8_dpp(float v) {
    v += __builtin_bit_cast(float, __builtin_amdgcn_mov_dpp(__builtin_bit_cast(int, v), 0xB1, 0xf, 0xf, true));
    v += __builtin_bit_cast(float, __builtin_amdgcn_mov_dpp(__builtin_bit_cast(int, v), 0x4E, 0xf, 0xf, true));
    v += __builtin_bit_cast(float, __builtin_amdgcn_mov_dpp(__builtin_bit_cast(int, v), 0x141, 0xf, 0xf, true));
    return v;
}
__device__ __forceinline__ float silu_f(float v) { return v * __builtin_amdgcn_rcpf(1.f + __expf(-v)); }
__device__ __forceinline__ float wave_sum(float v) {
    v += __builtin_bit_cast(float, __builtin_amdgcn_mov_dpp(__builtin_bit_cast(int, v), 0xB1, 0xf, 0xf, true));
    v += __builtin_bit_cast(float, __builtin_amdgcn_mov_dpp(__builtin_bit_cast(int, v), 0x4E, 0xf, 0xf, true));
    v += __builtin_bit_cast(float, __builtin_amdgcn_mov_dpp(__builtin_bit_cast(int, v), 0x141, 0xf, 0xf, true));
    v += __builtin_bit_cast(float, __builtin_amdgcn_mov_dpp(__builtin_bit_cast(int, v), 0x140, 0xf, 0xf, true));
    const int b = __builtin_bit_cast(int, v);
    return (__builtin_bit_cast(float, __builtin_amdgcn_readlane(b, 0)) + __builtin_bit_cast(float, __builtin_amdgcn_readlane(b, 16))) + (__builtin_bit_cast(float, __builtin_amdgcn_readlane(b, 32)) + __builtin_bit_cast(float, __builtin_amdgcn_readlane(b, 48)));
}
__device__ __forceinline__ int otid() { int t = threadIdx.x; asm volatile("" : "+v"(t)); return t; }
__device__ __forceinline__ const float* inptr(const Params& p, int i) { asm volatile("" : "+s"(i)); return p.in[i]; }
__device__ __forceinline__ bf16_t* mix_row(const Params& p, int row) { return row < NMAIN ? (bf16_t*)p.out + (size_t)row * D : (bf16_t*)(p.ws + WS_METAR) + (size_t)(row - NMAIN) * D; }
__device__ __forceinline__ bf16_t* y1_row(const Params& p, int row) { return row < NMAIN ? (bf16_t*)p.out + (size_t)(NMAIN + row) * D : (bf16_t*)(p.ws + WS_METAR + 524288) + (size_t)(row - NMAIN) * D; }
__device__ __forceinline__ f32x4 bf4(const u32x2 v) { return (f32x4){bf2f(v.x & 0xffff), bf2f(v.x >> 16), bf2f(v.y & 0xffff), bf2f(v.y >> 16)}; }

__device__ __forceinline__ int win_colmap(int np) {
    if (np < 2048) return np;
    if (np < 4160) return np + 8;
    if (np < 4168) return np - 4160 + 2048;
    if (np < 4176) return np;
    return -1;
}
template <class ColSrc>
__device__ __forceinline__ void transpose_tile(const ColSrc& cs, int ld, int k0, int n0, bf16_t* out, int Kout, LAS float* scr, int lane) {
    const float* colp = cs(n0 + (lane & 31));
#pragma unroll 8
    for (int i = 0; i < 32; ++i) { const int kk = 2 * i + (lane >> 5); scr[kk * 33 + (lane & 31)] = colp ? colp[(size_t)(k0 + kk) * ld] : 0.f; }
    asm volatile("s_waitcnt lgkmcnt(0)" ::: "memory");
    const int c = lane & 7;
#pragma unroll
    for (int j = 0; j < 4; ++j) {
        const int n = (lane >> 3) + 8 * j; const LAS float* s = scr + (8 * c) * 33 + n;
        u32x4 o; o.x = pk2(s[0 * 33], s[1 * 33]); o.y = pk2(s[2 * 33], s[3 * 33]); o.z = pk2(s[4 * 33], s[5 * 33]); o.w = pk2(s[6 * 33], s[7 * 33]);
        *(u32x4*)(out + (size_t)(n0 + n) * Kout + k0 + 8 * c) = o;
    }
    asm volatile("s_waitcnt lgkmcnt(0)" ::: "memory");
}


struct ColIdent { __device__ __forceinline__ int operator()(int n) const { return n; } };
template <class RowOf, class ColOf = ColIdent>
__device__ __forceinline__ void transpose_tile64(const float* W, int ld, int k0, int n0, bf16_t* out, int Kout, const RowOf& orow, LAS char* scr  , int lane, const ColOf& colof = ColOf()) {
    const int kr = lane >> 4, c4 = lane & 15;
    const int sc = colof(n0 + 4 * c4);
    f32x4 v[16];
#pragma unroll
    for (int i = 0; i < 16; ++i) v[i] = sc >= 0 ? __builtin_nontemporal_load((const f32x4*)(W + (size_t)(k0 + 4 * i + kr) * ld + sc)) : (f32x4){0.f, 0.f, 0.f, 0.f};
#pragma unroll
    for (int i = 0; i < 16; ++i)
#pragma unroll
        for (int e = 0; e < 4; ++e) *(LAS bf16_t*)(scr + (4 * c4 + e) * 144 + ((((i >> 1) ^ (c4 >> 1)) & 7) << 4) + (4 * (i & 1) + kr) * 2) = (bf16_t)f2bf(v[i][e]);
    asm volatile("s_waitcnt lgkmcnt(0)" ::: "memory");
#pragma unroll
    for (int j = 0; j < 8; ++j) {
        const int n = 8 * j + (lane >> 3), c = lane & 7;
        const u32x4 o = *(const LAS u32x4*)(scr + n * 144 + ((c ^ j) << 4));
        *(u32x4*)(out + (size_t)orow(n0 + n) * Kout + k0 + 8 * c) = o;
    }
    asm volatile("s_waitcnt lgkmcnt(0)" ::: "memory");
}

__device__ __forceinline__ void phase0(const Params& p, LAS char* lds) {
    const int tid = otid(), lane = tid & 63, wid = tid >> 6;
    const int gw = blockIdx.x * 8 + wid, NGW = gridDim.x * 8;
    const float* x = inptr(p, I_X); const float* meta = inptr(p, I_META);
    bf16_t* Hb = (bf16_t*)(p.ws + WS_BF);
    for (int row = gw; row < MROWS; row += NGW) {
        const float* src = row < NMAIN ? x + (size_t)row * D : (row < NROWS ? meta + (size_t)(row - NMAIN) * D : nullptr);
#pragma unroll
        for (int j = 0; j < 4; ++j) {
            f32x4 v = src ? __builtin_nontemporal_load((const f32x4*)(src + (lane + 64 * j) * 4)) : (f32x4){0.f, 0.f, 0.f, 0.f};
            u32x2 o; o.x = pk2(v.x, v.y); o.y = pk2(v.z, v.w);
            *(u32x2*)(Hb + (size_t)row * D + (lane + 64 * j) * 4) = o;
        }
    }
    {
        LAS char* scr = lds + wid * 9216;
        constexpr int IT_IN = 16 * (NPROJP / 64), IT_OUT = 16 * 16, IT_L = IT_IN + IT_OUT;
        for (int it = gw; it < 2 * IT_L; it += NGW) {
            const int l = it / IT_L; int r = it % IT_L;
            if (r < IT_IN) {
                const int kb = r / (NPROJP / 64), nb = r % (NPROJP / 64);
                auto colof = [&](int np) -> int { const int cg = np & 255, lc = (np & ~255) + ((cg >> 5) & 3) * 64 + (cg >> 7) * 32 + (cg & 31); return win_colmap(lc); };
                auto orow = [&](int n) -> int { return n; };
                transpose_tile64(inptr(p, I_WIN) + (size_t)l * D * 4176, 4176, kb * 64, nb * 64, (bf16_t*)(p.ws + WS_WIN) + (size_t)l * NPROJP * D, D, orow, scr, lane, colof);
            } else {
                r -= IT_IN;
                const int kb = r >> 4, nb = r & 15;
                auto orow = [&](int n) -> int { return n; };
                transpose_tile64(inptr(p, I_WOUT) + (size_t)l * D * D, D, kb * 64, nb * 64, (bf16_t*)(p.ws + WS_WOUT) + (size_t)l * D * D, D, orow, scr, lane);
            }
        }
    }
    for (int idx = blockIdx.x * NTHREADS + tid; idx < 2 * D * 36; idx += gridDim.x * NTHREADS) {
        const int l = idx / (D * 36), r = idx % (D * 36), c = r % 36, q = r / 36, ln = q & 63, ji = q >> 6, j = ji >> 2, i = ji & 3, k = 4 * (ln + 64 * j) + i;
        ((float*)(p.ws + WS_RW))[idx] = c < 4 ? inptr(p, I_WGRP)[((size_t)l * D + k) * 4 + c] : inptr(p, I_WRTR)[((size_t)l * D + k) * 32 + (c - 4)];
    }
}


constexpr int GT_PITCH = 144;
template <int MI, class Epi>
__device__ __forceinline__ void gemm_tile(LAS char* lds, const bf16_t* const (&ap)[2 * MI], const bf16_t* __restrict__ Bt, int K, const Epi& epi) {
    constexpr int BM = 128 * MI, A_BYTES = BM * GT_PITCH, B_BYTES = 128 * GT_PITCH, STG = A_BYTES + B_BYTES;
    const int tid = otid(), lane = tid & 63, wid = tid >> 6, wm = wid >> 1, wn = wid & 1, r32 = lane & 31, hh = lane >> 5;
    const bf16_t* bp[2];
#pragma unroll
    for (int i = 0; i < 2; ++i) { const int pi = tid + 512 * i; bp[i] = Bt + (size_t)(pi >> 3) * K + (pi & 7) * 8; }
    const int wofs = (tid >> 3) * GT_PITCH + (tid & 7) * 16;
    u32x4 ra0[2 * MI], rb0[2], ra1[2 * MI], rb1[2];
    f32x16 acc[MI][2];
#pragma unroll
    for (int a = 0; a < MI; ++a)
#pragma unroll
        for (int b = 0; b < 2; ++b)
#pragma unroll
            for (int r = 0; r < 16; ++r) acc[a][b][r] = 0.f;
    const int nk = K >> 6;
#define GT_LOAD(RA, RB, kt_) do { _Pragma("unroll") for (int i = 0; i < 2 * MI; ++i) RA[i] = *(const u32x4*)(ap[i] + (kt_) * 64); _Pragma("unroll") for (int i = 0; i < 2; ++i) RB[i] = *(const u32x4*)(bp[i] + (kt_) * 64); } while (0)
#define GT_WRITE(RA, RB, st_) do { LAS char* sn_ = lds + (st_) * STG; _Pragma("unroll") for (int i = 0; i < 2 * MI; ++i) *(LAS u32x4*)(sn_ + wofs + i * 64 * GT_PITCH) = RA[i]; _Pragma("unroll") for (int i = 0; i < 2; ++i) *(LAS u32x4*)(sn_ + A_BYTES + wofs + i * 64 * GT_PITCH) = RB[i]; } while (0)
    const int aoff = (wm * 32 * MI + r32) * GT_PITCH + hh * 16, boff = A_BYTES + (wn * 64 + r32) * GT_PITCH + hh * 16;
#define GT_COMPUTE(st_) do { LAS char* st = lds + (st_) * STG; _Pragma("unroll") for (int s = 0; s < 4; ++s) { bf16x8 af[MI], bfr[2]; \
        _Pragma("unroll") for (int a = 0; a < MI; ++a) af[a] = *(const LAS bf16x8*)(st + aoff + a * 32 * GT_PITCH + s * 32); \
        _Pragma("unroll") for (int b = 0; b < 2; ++b) bfr[b] = *(const LAS bf16x8*)(st + boff + b * 32 * GT_PITCH + s * 32); \
        _Pragma("unroll") for (int a = 0; a < MI; ++a) _Pragma("unroll") for (int b = 0; b < 2; ++b) acc[a][b] = __builtin_amdgcn_mfma_f32_32x32x16_bf16(bfr[b], af[a], acc[a][b], 0, 0, 0); } } while (0)
    GT_LOAD(ra0, rb0, 0); GT_LOAD(ra1, rb1, 1);
    GT_WRITE(ra0, rb0, 0);
    __syncthreads();
    for (int kt = 0; kt < nk; kt += 2) {
        if (kt + 2 < nk) GT_LOAD(ra0, rb0, kt + 2);
        GT_COMPUTE(0);
        GT_WRITE(ra1, rb1, 1);
        __syncthreads();
        if (kt + 3 < nk) GT_LOAD(ra1, rb1, kt + 3);
        GT_COMPUTE(1);
        if (kt + 2 < nk) GT_WRITE(ra0, rb0, 0);
        __syncthreads();
    }
#undef GT_LOAD
#undef GT_WRITE
#undef GT_COMPUTE
#pragma unroll
    for (int a = 0; a < MI; ++a) epi(wm * 32 * MI + a * 32 + r32, wn * 64, acc[a][0], acc[a][1]);
}

namespace pg8 {
#define PG8_LAS __attribute__((address_space(3)))
typedef unsigned short bf16_t;
typedef short bf16x8 __attribute__((ext_vector_type(8)));
typedef float f32x4 __attribute__((ext_vector_type(4)));
typedef unsigned u32x4 __attribute__((ext_vector_type(4)));
constexpr int BM = 256, BK = 64, HALF = 128, HTB = HALF * BK * 2  , STAGE_BYTES = 8 * HTB, NXCD = 8, WGM = 4;

__host__ __device__ __forceinline__ int lds_byte(int r, int c) { const int st = (r >> 4) * 2 + (c >> 5), rr = r & 15, cc = c & 31, ob = rr * 64 + cc * 2; return st * 1024 + (ob ^ (((ob >> 9) & 1) << 5)); }
__host__ __device__ __forceinline__ void stage_rc(int b, int& R, int& C) { const int st = b / 1024, sb = b % 1024, swz = sb ^ (((sb >> 9) & 1) << 5); R = (st >> 1) * 16 + swz / 64; C = (st & 1) * 32 + (swz % 64) / 2; }
__host__ __device__ __forceinline__ int perm32(int rho) { const int n = rho >> 4, i = rho & 15; return 8 * (i >> 2) + 4 * n + (i & 3); }

struct Unit { int pm, pn; int ue = 0, um = 0; size_t bo = 0; };
struct Gemm { const bf16_t* A; const bf16_t* Bt; int M, N, K; };

struct StaticOrder {
    int nM, nN, nwg, G, c;
    __host__ __device__ void init(int M, int N, int G_, int c_) { nM = M / BM; nN = N / BM; nwg = nM * nN; G = G_; c = c_; }
    __host__ __device__ bool next(int i, Unit& u) const {
        const long L = (long)i * G + c; if (L >= nwg) return false;
        int wgid = (int)L; { const int q = nwg / NXCD, r = nwg % NXCD, xcd = wgid % NXCD, off = wgid / NXCD; wgid = (xcd < r ? xcd * (q + 1) : r * (q + 1) + (xcd - r) * q) + off; }
        const int nig = WGM * nN, gid = wgid / nig, fm = gid * WGM, gsz = (nM - fm) < WGM ? (nM - fm) : WGM;
        u.pm = fm + ((wgid % nig) % gsz); u.pn = (wgid % nig) / gsz; return true;
    }
    __device__ __forceinline__ void a_ready(const Unit&) const {}
    __device__ __forceinline__ void done(const Unit&) const {}
};


template <class Epi, class Sched, bool ALIGN_EPI = false, bool SP2 = false>
__device__ __forceinline__ void gemm_phase(PG8_LAS unsigned char* lds, const Gemm g, const Sched& S, const Epi& E) {
    const int tid = otid(), wid = __builtin_amdgcn_readfirstlane(tid >> 6), lane = tid & 63, wr = wid >> 2, wc = wid & 3, fr = lane & 15, fq = lane >> 4;
    const int K = g.K, nt = K / BK;
    unsigned voffA[2], voffB[2];
#pragma unroll
    for (int i = 0; i < 2; ++i) { int R, C; stage_rc(tid * 16 + i * 8192, R, C); const int Rb = Epi::PERM ? ((R & ~31) + perm32(R & 31)) : R;
        voffA[i] = (unsigned)(R * K + C) * 2u; voffB[i] = (unsigned)(Rb * K + C) * 2u; }
    const size_t kstep = (size_t)(BK * 2);
    const size_t hstep = (size_t)HALF * K * 2;
    const size_t tstep = 2 * hstep;
    const unsigned ldsw = (unsigned)wid * 1024u;
    const int aoff = lds_byte(wr * 64 + fr, fq * 8), boff = lds_byte(wc * 32 + fr, fq * 8);
#define PG8_SA(b, h) (((b) * 2 + (h)) * HTB)
#define PG8_SB(b, h) ((4 + (b) * 2 + (h)) * HTB)
#define PG8_STAGE(bufoff, gbase, voff) do { _Pragma("unroll") for (int _i = 0; _i < 2; ++_i) \
        __builtin_amdgcn_global_load_lds((const unsigned*)((const char*)(gbase) + (voff)[_i]), (PG8_LAS unsigned*)(lds + (bufoff) + ldsw + _i * 8192), 16, 0, 0); } while (0)
#define PG8_LDA(dst, b, h) do { _Pragma("unroll") for (int m = 0; m < 4; ++m) _Pragma("unroll") for (int k = 0; k < 2; ++k) dst[m][k] = *(const PG8_LAS bf16x8*)(lds + PG8_SA(b, h) + aoff + m * 2048 + k * 1024); } while (0)
#define PG8_LDB(dst, b, h) do { _Pragma("unroll") for (int n = 0; n < 2; ++n) _Pragma("unroll") for (int k = 0; k < 2; ++k) dst[n][k] = *(const PG8_LAS bf16x8*)(lds + PG8_SB(b, h) + boff + n * 2048 + k * 1024); } while (0)
#define PG8_MMA(ai, bj, At, Bt) do { __builtin_amdgcn_s_setprio(1); _Pragma("unroll") for (int m = 0; m < 4; ++m) _Pragma("unroll") for (int n = 0; n < 2; ++n) _Pragma("unroll") for (int k = 0; k < 2; ++k) \
        acc[ai][bj][m][n] = __builtin_amdgcn_mfma_f32_16x16x32_bf16(Bt[n][k], At[m][k], acc[ai][bj][m][n], 0, 0, 0); __builtin_amdgcn_s_setprio(0); } while (0)
#define PG8_WAIT_V(n) asm volatile("s_waitcnt vmcnt(" #n ")" ::: "memory")
#define PG8_WAIT_L(n) asm volatile("s_waitcnt lgkmcnt(" #n ")" ::: "memory")
#define PG8_BAR __builtin_amdgcn_s_barrier()
#define PG8_SCHED __builtin_amdgcn_sched_barrier(0)
    Unit cur, nxt; int ui = 0;
    if (!S.next(0, cur)) return;
    f32x4 acc[2][2][4][2];
#pragma unroll
    for (int a = 0; a < 2; ++a)
#pragma unroll
        for (int b = 0; b < 2; ++b)
#pragma unroll
            for (int m = 0; m < 4; ++m)
#pragma unroll
                for (int n = 0; n < 2; ++n) acc[a][b][m][n] = (f32x4){0.f, 0.f, 0.f, 0.f};
    bf16x8 At[4][2], B0[2][2], B1[2][2];
    const char* cA = (const char*)g.A + (size_t)cur.pm * tstep; const char* cB = (const char*)g.Bt + cur.bo + (size_t)cur.pn * tstep;
    S.a_ready(cur);
    if constexpr (SP2) {
        PG8_STAGE(PG8_SB(0, 0), cB, voffB); PG8_STAGE(PG8_SB(0, 1), cB + hstep, voffB); PG8_STAGE(PG8_SA(0, 0), cA, voffA); PG8_STAGE(PG8_SA(0, 1), cA + hstep, voffA);
        if (wr == 1) PG8_BAR;
        PG8_WAIT_V(2); PG8_BAR;
        PG8_STAGE(PG8_SB(1, 0), cB + kstep, voffB); PG8_STAGE(PG8_SA(1, 0), cA + kstep, voffA); PG8_STAGE(PG8_SB(1, 1), cB + hstep + kstep, voffB);
        PG8_WAIT_V(6); PG8_BAR;
    } else {
        PG8_STAGE(PG8_SB(0, 0), cB, voffB); PG8_STAGE(PG8_SA(0, 0), cA, voffA); PG8_STAGE(PG8_SB(0, 1), cB + hstep, voffB); PG8_STAGE(PG8_SA(0, 1), cA + hstep, voffA);
        if (wr == 1) PG8_BAR;
        PG8_WAIT_V(4); PG8_BAR;
        PG8_STAGE(PG8_SB(1, 0), cB + kstep, voffB); PG8_STAGE(PG8_SA(1, 0), cA + kstep, voffA); PG8_STAGE(PG8_SB(1, 1), cB + hstep + kstep, voffB);
        PG8_WAIT_V(6); PG8_BAR;
    }
    for (;;) {
        const bool has_next = S.next(ui + 1, nxt);
        const char* nA = has_next ? (const char*)g.A + (size_t)nxt.pm * tstep : cA; const char* nB = has_next ? (const char*)g.Bt + nxt.bo + (size_t)nxt.pn * tstep : cB;
        for (int t = 0; t < nt; t += 2) {
            const bool last = (t == nt - 2);
            const char* a1 = cA + (size_t)(t + 1) * kstep;
            const char* a2 = last ? nA : cA + (size_t)(t + 2) * kstep; const char* b2 = last ? nB : cB + (size_t)(t + 2) * kstep;
            const char* a3 = a2 + kstep; const char* b3 = b2 + kstep;
            if (last && has_next) S.a_ready(nxt);
            if constexpr (SP2) {
            PG8_LDB(B0, 0, 0); PG8_LDB(B1, 0, 1); PG8_SCHED; PG8_LDA(At, 0, 0); PG8_STAGE(PG8_SA(1, 1), a1 + hstep, voffA);
            PG8_WAIT_V(8); PG8_WAIT_L(0); PG8_BAR; PG8_MMA(0, 0, At, B0); PG8_MMA(0, 1, At, B1); PG8_BAR; PG8_SCHED;
            PG8_LDA(At, 0, 1); PG8_STAGE(PG8_SB(0, 0), b2, voffB); PG8_STAGE(PG8_SB(0, 1), b2 + hstep, voffB); PG8_STAGE(PG8_SA(0, 0), a2, voffA);
            PG8_WAIT_V(8); PG8_WAIT_L(0); PG8_BAR; PG8_MMA(1, 0, At, B0); PG8_MMA(1, 1, At, B1); PG8_BAR; PG8_SCHED;
            PG8_LDB(B0, 1, 0); PG8_LDB(B1, 1, 1); PG8_SCHED; PG8_LDA(At, 1, 0); PG8_STAGE(PG8_SA(0, 1), a2 + hstep, voffA);
            PG8_WAIT_V(8); PG8_WAIT_L(0); PG8_BAR; PG8_MMA(0, 0, At, B0); PG8_MMA(0, 1, At, B1); PG8_BAR; PG8_SCHED;
            PG8_LDA(At, 1, 1); PG8_STAGE(PG8_SB(1, 0), b3, voffB); PG8_STAGE(PG8_SB(1, 1), b3 + hstep, voffB); PG8_STAGE(PG8_SA(1, 0), a3, voffA);
            PG8_WAIT_V(8); PG8_WAIT_L(0); PG8_BAR; PG8_MMA(1, 0, At, B0); PG8_MMA(1, 1, At, B1); PG8_BAR; PG8_SCHED;
            } else {
            PG8_LDB(B0, 0, 0); PG8_SCHED; PG8_LDA(At, 0, 0); PG8_STAGE(PG8_SA(1, 1), a1 + hstep, voffA);
            PG8_WAIT_L(8); PG8_BAR; PG8_WAIT_L(0); PG8_MMA(0, 0, At, B0); PG8_BAR; PG8_SCHED;
            PG8_LDB(B1, 0, 1); PG8_STAGE(PG8_SB(0, 0), b2, voffB);
            PG8_BAR; PG8_WAIT_L(0); PG8_MMA(0, 1, At, B1); PG8_BAR;
            PG8_LDA(At, 0, 1); PG8_STAGE(PG8_SA(0, 0), a2, voffA);
            PG8_BAR; PG8_WAIT_L(0); PG8_MMA(1, 0, At, B0); PG8_BAR; PG8_SCHED;
            PG8_STAGE(PG8_SB(0, 1), b2 + hstep, voffB);
            PG8_WAIT_V(6); PG8_BAR; PG8_MMA(1, 1, At, B1); PG8_BAR;
            PG8_LDB(B0, 1, 0); PG8_SCHED; PG8_LDA(At, 1, 0); PG8_STAGE(PG8_SA(0, 1), a2 + hstep, voffA);
            PG8_WAIT_L(8); PG8_BAR; PG8_WAIT_L(0); PG8_MMA(0, 0, At, B0); PG8_BAR; PG8_SCHED;
            PG8_LDB(B1, 1, 1); PG8_STAGE(PG8_SB(1, 0), b3, voffB);
            PG8_BAR; PG8_WAIT_L(0); PG8_MMA(0, 1, At, B1); PG8_BAR;
            PG8_LDA(At, 1, 1); PG8_STAGE(PG8_SA(1, 0), a3, voffA);
            PG8_BAR; PG8_WAIT_L(0); PG8_MMA(1, 0, At, B0); PG8_BAR; PG8_SCHED;
            PG8_STAGE(PG8_SB(1, 1), b3 + hstep, voffB);
            PG8_WAIT_V(6); PG8_BAR; PG8_MMA(1, 1, At, B1); PG8_BAR;
            }
        }
        if constexpr (ALIGN_EPI) { if (wr == 0) PG8_BAR; }
        if constexpr (!Epi::AFTER_DRAIN) { E(acc, cur, wr, wc, fr, fq); S.done(cur); }
        if (!has_next) break;
#pragma unroll
        for (int a = 0; a < 2; ++a)
#pragma unroll
            for (int b = 0; b < 2; ++b)
#pragma unroll
                for (int m = 0; m < 4; ++m)
#pragma unroll
                    for (int n = 0; n < 2; ++n) acc[a][b][m][n] = (f32x4){0.f, 0.f, 0.f, 0.f};
        cur = nxt; cA = nA; cB = nB; ++ui;
        if constexpr (ALIGN_EPI) { if (wr == 1) PG8_BAR; }
    }
    PG8_WAIT_V(0);
    if constexpr (!ALIGN_EPI) { if (wr == 0) PG8_BAR; }
    PG8_BAR;
    if constexpr (Epi::AFTER_DRAIN) { E.fused(acc, cur, wr, wc, fr, fq, lds, wid, lane); S.done(cur); }
#undef PG8_SA
#undef PG8_SB
#undef PG8_STAGE
#undef PG8_LDA
#undef PG8_LDB
#undef PG8_MMA
#undef PG8_WAIT_V
#undef PG8_WAIT_L
#undef PG8_BAR
#undef PG8_SCHED
}
}

__device__ __forceinline__ void phaseG(const Params& p, int layer, int nrows, bool last) {
    const int tid = otid(), lane = tid & 63, wid = tid >> 6;
    const int gw = blockIdx.x * 8 + wid, NGW = gridDim.x * 8;
    const float* g = inptr(p, I_LN2G) + layer * D; const float* bb = inptr(p, I_LN2B) + layer * D;
    bf16_t* Hb = (bf16_t*)(p.ws + WS_BF);
    const bf16_t* EO = (const bf16_t*)(p.ws + WS_EO);
    u32x2 hn[4], e0n[4], e1n[4];
    auto pre = [&](int row) {
#pragma unroll
        for (int j = 0; j < 4; ++j) {
            hn[j] = *(const u32x2*)(Hb + (size_t)row * D + (lane + 64 * j) * 4);
            e0n[j] = __builtin_nontemporal_load((const u32x2*)(EO + (size_t)row * D + (lane + 64 * j) * 4)); e1n[j] = __builtin_nontemporal_load((const u32x2*)(EO + (size_t)(MROWS + row) * D + (lane + 64 * j) * 4));
        }
    };
    if (gw < nrows) pre(gw);
    f32x4 gv[4], bv4[4];
#pragma unroll
    for (int j = 0; j < 4; ++j) { gv[j] = *(const f32x4*)(g + (lane + 64 * j) * 4); bv4[j] = *(const f32x4*)(bb + (lane + 64 * j) * 4); }
    for (int row = gw; row < nrows; row += NGW) {
        f32x4 v[4]; float s = 0.f;
#pragma unroll
        for (int j = 0; j < 4; ++j) { v[j] = bf4(hn[j]) * ALPHA + bf4(e0n[j]) + bf4(e1n[j]); s += (v[j].x + v[j].y) + (v[j].z + v[j].w); }
        if (row + NGW < nrows) pre(row + NGW);
        const float mean = wave_sum(s) * (1.f / D); float s2 = 0.f;
#pragma unroll
        for (int j = 0; j < 4; ++j) { v[j] = v[j] - mean; s2 += (v[j].x * v[j].x + v[j].y * v[j].y) + (v[j].z * v[j].z + v[j].w * v[j].w); }
        const float rstd = 1.f / sqrtf(wave_sum(s2) * (1.f / D) + 1e-5f);
#pragma unroll
        for (int j = 0; j < 4; ++j) {
            const f32x4 o = v[j] * rstd * gv[j] + bv4[j];
            if (last) __builtin_nontemporal_store(o, (f32x4*)(p.out + (size_t)row * D + (lane + 64 * j) * 4));
            else {
                u32x2 ob; ob.x = pk2(o.x, o.y); ob.y = pk2(o.z, o.w);
                *(u32x2*)(Hb + (size_t)row * D + (lane + 64 * j) * 4) = ob;
            }
        }
    }
}

__device__ __forceinline__ int row_pos(int row) { return row < NMAIN ? (row & (SEQ - 1)) + NMETA : (row < NROWS ? row - NMAIN : 0); }
constexpr float QSCALE = 0.125f * 1.4426950408889634f;
struct EpiInProj {
    static constexpr bool PERM = true, AFTER_DRAIN = false;
    unsigned char* ws;
    __device__ __forceinline__ void operator()(const pg8::f32x4 (&acc)[2][2][4][2], const pg8::Unit& u, int, int, int, int) const {
        const int tid_ = otid(), wid_ = __builtin_amdgcn_readfirstlane(tid_ >> 6), wr = wid_ >> 2, wc = wid_ & 3, fr = tid_ & 15, fq = (tid_ >> 4) & 3;
        const int pn = u.pn;
        bf16_t* PROJ = (bf16_t*)(ws + WS_PROJ); bf16_t* IK = (bf16_t*)(ws + WS_IK); float* PX = (float*)(ws + WS_PX);
        if (pn == 16 && wc >= 2) return;
#pragma unroll
        for (int ai = 0; ai < 2; ++ai)
#pragma unroll
            for (int m = 0; m < 4; ++m) {
                const int row = u.pm * 256 + ai * 128 + wr * 64 + m * 16 + fr;
                if (pn < 8 || pn == 12 || pn == 13) {
                    bf16_t* dst = PROJ + (size_t)row * 4096 + pn * 256 + wc * 64 + 8 * fq;
#pragma unroll
                    for (int bj = 0; bj < 2; ++bj) {
                        const pg8::f32x4 v0 = acc[ai][bj][m][0], v1 = acc[ai][bj][m][1];
                        *(u32x4*)(dst + 32 * bj) = (u32x4){pk2(v0[0], v0[1]), pk2(v0[2], v0[3]), pk2(v1[0], v1[1]), pk2(v1[2], v1[3])};
                    }
                } else if (pn < 16 || wc == 0) {
                    const int t = row_pos(row);
                    const float sc = pn < 10 ? QSCALE : 1.f;
                    bf16_t* dst = (pn < 16 ? PROJ + (size_t)row * 4096 + pn * 256 + wc * 64 : IK + (size_t)row * 64) + 8 * fq;
#pragma unroll
                    for (int n = 0; n < 2; ++n) {
                        f32x4 cs, sn;
#pragma unroll
                        for (int j = 0; j < 4; ++j) {
                            const float rev = (float)t * __builtin_amdgcn_exp2f((float)(8 * fq + 4 * n + j) * -0.41524101186092f - 2.651496129472319f);
                            const float fr_ = __builtin_amdgcn_fractf(rev);
                            cs[j] = __builtin_amdgcn_cosf(fr_); sn[j] = __builtin_amdgcn_sinf(fr_);
                        }
                        const pg8::f32x4 x1 = acc[ai][0][m][n], x2 = acc[ai][1][m][n];
                        const f32x4 a = (x1 * cs - x2 * sn) * sc, b = (x2 * cs + x1 * sn) * sc;
                        *(u32x2*)(dst + 4 * n) = (u32x2){pk2(a[0], a[1]), pk2(a[2], a[3])};
                        *(u32x2*)(dst + 32 + 4 * n) = (u32x2){pk2(b[0], b[1]), pk2(b[2], b[3])};
                    }
                } else if (fq < 2) {
                    float* dst = PX + (size_t)row * 16 + 8 * fq;
                    *(f32x4*)dst = acc[ai][0][m][0]; *(f32x4*)(dst + 4) = acc[ai][0][m][1];
                }
                asm volatile("" ::: "memory");
            }
    }
};
__device__ __forceinline__ void phaseA(const Params& p, int l, LAS char* lds) {
    pg8::Gemm g{(const bf16_t*)(p.ws + WS_BF), (const bf16_t*)(p.ws + WS_WIN) + (size_t)l * NPROJP * D, MROWS, NPROJP, D};
    pg8::StaticOrder S; S.init(MROWS, NPROJP, (int)gridDim.x, (int)blockIdx.x);
    EpiInProj E{p.ws};
    pg8::gemm_phase<EpiInProj, pg8::StaticOrder, true, true>((PG8_LAS unsigned char*)lds, g, S, E);
}

struct SchedCE {
    int mode; pg8::StaticOrder so; int G, c;
    __device__ __forceinline__ bool next(int i, pg8::Unit& u) const {
        if (mode == 0) return so.next(i, u);
        const LAS int* tab = (const LAS int*)(uintptr_t)131072;
        const int L = i * G + c, gt = L >> 2;
        if (gt >= __builtin_amdgcn_readfirstlane(tab[64])) return false;
        int lo = 0;
#pragma unroll
        for (int s = 16; s > 0; s >>= 1) if (__builtin_amdgcn_readfirstlane(tab[32 + lo + s]) <= gt) lo += s;
        u.pm = gt; u.pn = L & 3; u.ue = lo; u.um = gt - __builtin_amdgcn_readfirstlane(tab[32 + lo]); u.bo = (size_t)lo * D * DEXP * 2;
        return true;
    }
    __device__ __forceinline__ void a_ready(const pg8::Unit&) const {}
    __device__ __forceinline__ void done(const pg8::Unit&) const {}
};
struct EpiCE {
    static constexpr bool PERM = true, AFTER_DRAIN = false;
    int mode; unsigned char* ws; bf16_t* dout;
    __device__ __forceinline__ void operator()(const pg8::f32x4 (&acc)[2][2][4][2], const pg8::Unit& u, int, int, int, int) const {
        const LAS int* tab = (const LAS int*)(uintptr_t)131072; const unsigned* list = (const unsigned*)(ws + WS_LIST); bf16_t* EO = (bf16_t*)(ws + WS_EO);
        const int tid_ = otid(), wid_ = __builtin_amdgcn_readfirstlane(tid_ >> 6), wr = wid_ >> 2, wc = wid_ & 3, fr = tid_ & 15, fq = (tid_ >> 4) & 3;
        const int cexp = mode ? tab[u.ue] : 0;
        unsigned enta = 0u, entb = 0u;
        if (mode) { const int i0 = u.um * 256 + wr * 64 + (tid_ & 63); enta = i0 < cexp ? list[u.ue * LIST_CAP + i0] : 0u; entb = i0 + 128 < cexp ? list[u.ue * LIST_CAP + i0 + 128] : 0u; }
#pragma unroll
        for (int ai = 0; ai < 2; ++ai)
#pragma unroll
            for (int m = 0; m < 4; ++m) {
                const int rloc = ai * 128 + wr * 64 + m * 16 + fr, coff = u.pn * 256 + wc * 32 + 8 * fq;
                const unsigned entg = mode ? (unsigned)__shfl((int)(ai ? entb : enta), m * 16 + fr) : 0u;
                if (mode == 0) {
                    const size_t off = (size_t)(u.pm * 256 + rloc) * D + coff;
#pragma unroll
                    for (int bj = 0; bj < 2; ++bj) {
                        const pg8::f32x4 y0 = acc[ai][bj][m][0], y1v = acc[ai][bj][m][1];
                        *(u32x4*)(dout + (size_t)NMAIN * D + off + bj * 128) = (u32x4){pk2(y0[0], y0[1]), pk2(y0[2], y0[3]), pk2(y1v[0], y1v[1]), pk2(y1v[2], y1v[3])};
                    }
                } else {
                    const int idx = u.um * 256 + rloc;
                    if (idx < cexp) {
                        const unsigned ent = entg;
                        bf16_t* dst = EO + ((size_t)(ent & 1u) * MROWS + (ent >> 1)) * D + coff;
#pragma unroll
                        for (int bj = 0; bj < 2; ++bj) {
                            const pg8::f32x4 v0 = acc[ai][bj][m][0], v1 = acc[ai][bj][m][1];
                            *(u32x4*)(dst + 128 * bj) = (u32x4){pk2(v0[0], v0[1]), pk2(v0[2], v0[3]), pk2(v1[0], v1[1]), pk2(v1[2], v1[3])};
                        }
                    }
                }
                asm volatile("" ::: "memory");
            }
    }
};
constexpr int MOE_TAB_EARLY = 131072;
__device__ __forceinline__ void moe_build_table(const unsigned* cnt, LAS int* tab);
__device__ __forceinline__ void phaseCE(const Params& p, int l, LAS char* lds, int mode) {
    const bf16_t* MIX = (const bf16_t*)p.out;
    const bf16_t* Wt = (const bf16_t*)(p.ws + WS_WOUT) + (size_t)l * D * D;
    {
        LAS int* tab = (LAS int*)(lds + MOE_TAB_EARLY);
        if (mode) moe_build_table((const unsigned*)(p.ws + WS_CTL) + 256 + l * 64, tab);
        pg8::Gemm g{mode ? (const bf16_t*)(p.ws + WS_HID) : MIX, mode ? (const bf16_t*)(p.ws + WS_W2T) : Wt, mode ? 0 : NMAIN, D, mode ? DEXP : D};
        SchedCE S; S.mode = mode; S.so.init(NMAIN, D, (int)gridDim.x, (int)blockIdx.x); S.G = (int)gridDim.x; S.c = (gridDim.x == 256) ? (int)(((blockIdx.x & 7) << 5) | (blockIdx.x >> 3)) : (int)blockIdx.x;
        EpiCE E{mode, p.ws, (bf16_t*)p.out};
        pg8::gemm_phase<EpiCE, SchedCE, true, true>((PG8_LAS unsigned char*)lds, g, S, E);
    }
    if (mode) return;
    if (l == 0 && blockIdx.x < 64) {
        typedef float f32x4v __attribute__((ext_vector_type(4)));
        const int tid = otid(), lane = tid & 63, wid = tid >> 6;
        const int n0 = blockIdx.x * 16, r16 = lane & 15, q = lane >> 4;
        const bf16_t* ar = mix_row(p, NMAIN + r16) + 8 * q + 128 * wid; const bf16_t* br = Wt + (size_t)(n0 + r16) * D + 8 * q + 128 * wid;
        bf16x8 a[4], bq[4];
#pragma unroll
        for (int s = 0; s < 4; ++s) { a[s] = *(const bf16x8*)(ar + 32 * s); bq[s] = *(const bf16x8*)(br + 32 * s); }
        f32x4v acc = (f32x4v){0.f, 0.f, 0.f, 0.f};
#pragma unroll
        for (int s = 0; s < 4; ++s) acc = __builtin_amdgcn_mfma_f32_16x16x32_bf16(bq[s], a[s], acc, 0, 0, 0);
        LAS f32x4* red = (LAS f32x4*)lds;
        red[wid * 64 + lane] = (f32x4){acc[0], acc[1], acc[2], acc[3]};
        __syncthreads();
        if (wid == 0) {
            f32x4 sum = red[lane];
#pragma unroll
            for (int w = 1; w < 8; ++w) sum += red[w * 64 + lane];
            const size_t moff = (size_t)r16 * D + n0 + 4 * q;
            const f32x4 y = sum;
            *(u32x2*)(y1_row(p, NMAIN) + moff) = (u32x2){pk2(y.x, y.y), pk2(y.z, y.w)};
        }
    }
}


__device__ __forceinline__ void mm16_acc(float (&c)[4], const LAS float* A, int pa, const LAS float* B, int pb, int lane) {
    typedef float f32x4v __attribute__((ext_vector_type(4)));
    const int i = lane & 15, kq = lane >> 4;
    f32x4v acc = (f32x4v){c[0], c[1], c[2], c[3]};
#pragma unroll
    for (int kk = 0; kk < 4; ++kk) acc = __builtin_amdgcn_mfma_f32_16x16x4f32(A[i * pa + 4 * kk + kq], B[(4 * kk + kq) * pb + i], acc, 0, 0, 0);
#pragma unroll
    for (int r = 0; r < 4; ++r) c[r] = acc[r];
}
__device__ __forceinline__ void mm16_store(const float (&c)[4], float sgn, LAS float* Dst, int pd, int lane) {
    const int r0 = 4 * (lane >> 4), cc = lane & 15;
#pragma unroll
    for (int r = 0; r < 4; ++r) Dst[(r0 + r) * pd + cc] = sgn * c[r];
}
__device__ __forceinline__ int tok_row(int b, int t) { return t < NMETA ? NMAIN + t : b * SEQ + (t - NMETA); }
constexpr int DN_ITEM_BYTES = 73728;
constexpr int DN_W = 0, DN_QD = 16384, DN_KDT = 32768, DN_U = 49152, DN_AQK = 65536;
constexpr int DL_KB = 0, DL_KN = 17408, DL_QS = 34816, DL_VBT = 52224, DL_KBDT = 70656, DL_A = 89088, DL_THI = 106496, DL_TLO = 115712, DL_TF = 124928, DL_BETA = 142336, DL_GC = 142592, DL_CW = 142848  , DL_RAW = 89088  ;
__device__ __forceinline__ void dn_intra_item(const Params& p, int l, int item, LAS char* lds, unsigned* qctr, bool claim, int& nxt) {
    const int tid = otid(), lane = tid & 63, wid = tid >> 6, r32 = lane & 31, hh = lane >> 5;
    const int n = item % 33, bh = item / 33, h = bh & 3, b = bh >> 2;
    const bf16_t* PROJ = (const bf16_t*)(p.ws + WS_PROJ); const float* PX = (const float*)(p.ws + WS_PX);
    unsigned char* ib = p.ws + WS_X + (size_t)item * DN_ITEM_BYTES;
    LAS float* Lbeta = (LAS float*)(lds + DL_BETA); LAS float* Lgc = (LAS float*)(lds + DL_GC);
    const int tfirst = (n == 0) ? -48 : NMETA + 64 * (n - 1);
    u32x4 rr[7];
#pragma unroll
    for (int k = 0; k < 7; ++k) {
        const int pi = tid + 512 * k, r = pi / 48, c = pi % 48, t = tfirst - 3 + r;
        rr[k] = (pi < 67 * 48 && t >= 0) ? *(const u32x4*)(PROJ + (size_t)tok_row(b, t) * 4096 + (c >> 4) * 512 + h * 128 + (c & 15) * 8) : (u32x4){0u, 0u, 0u, 0u};
    }
    f32x4 wv = (f32x4){0.f, 0.f, 0.f, 0.f};
    if (tid < 384) { const int j = tid / 96, c4 = tid % 96; wv = *(const f32x4*)(inptr(p, I_CONV) + ((size_t)l * 4 + j) * 1536 + (c4 >> 5) * 512 + h * 128 + (c4 & 31) * 4); }
    const int tz = (n == 0) ? (tid >> 3) - 48 : NMETA + 64 * (n - 1) + (tid >> 3);
    const bool zown = tz >= 0 && (n > 0 || b == 0);
    bf16_t* zp = (bf16_t*)(p.ws + WS_PROJ) + (size_t)tok_row(b, zown ? tz : 0) * 4096 + 1536 + h * 128 + 16 * (tid & 7);
    u32x4 z0 = (u32x4){0u, 0u, 0u, 0u}, z1 = z0;
    if (zown) { z0 = *(const u32x4*)zp; z1 = *(const u32x4*)(zp + 8); }
    f32x4 ngv[4];
#pragma unroll
    for (int e4 = 0; e4 < 4; ++e4) ngv[e4] = *(const f32x4*)(inptr(p, I_DNG) + l * 128 + 16 * (tid & 7) + 4 * e4);
    if (wid == 0) {
        const int t = (n == 0) ? lane - 48 : NMETA + 64 * (n - 1) + lane; const bool valid = t >= 0;
        const int row = valid ? tok_row(b, t) : 0;
        const float bl = PX[row * 16 + h], al = PX[row * 16 + 4 + h];
        const float beta = valid ? 1.f / (1.f + __expf(-bl)) : 0.f;
        const float x = al + inptr(p, I_DTB)[l * 4 + h]; const float ex = __expf(x); const float sp = x > 20.f ? x : (ex < 0.01f ? ex * (1.f - ex * (0.5f - ex * 0.33333334f)) : __logf(1.f + ex));
        const float g = valid ? -__expf(inptr(p, I_ALOG)[l * 4 + h]) * sp : 0.f;
        float gc = g;
#pragma unroll
        for (int o = 1; o < 64; o <<= 1) { const float y = __shfl_up(gc, o); if (lane >= o) gc += y; }
        Lbeta[lane] = beta; Lgc[lane] = gc;
        if (lane == 63) ((float*)(p.ws + WS_GL))[item] = gc;
    }
    {
#pragma unroll
        for (int k = 0; k < 7; ++k) { const int pi = tid + 512 * k, r = pi / 48, c = pi % 48; if (pi < 67 * 48) *(LAS u32x4*)(lds + DL_RAW + r * 784 + ((c >> 4) * 128 + (c & 15) * 8) * 2) = rr[k]; }
        if (tid < 384) { const int j = tid / 96, c4 = tid % 96; *(LAS f32x4*)(lds + DL_CW + (j * 384 + (c4 >> 5) * 128 + (c4 & 31) * 4) * 4) = wv; }
    }
    __syncthreads();
    if (claim && tid == 0) { unsigned zoff = 0u; asm volatile("" : "+v"(zoff)); nxt = (int)__hip_atomic_fetch_add(qctr + zoff, 1u, __ATOMIC_RELAXED, __HIP_MEMORY_SCOPE_AGENT); }
    {
        const int i = tid >> 3, part = tid & 7;
        const float beta = Lbeta[i], gc = Lgc[i], gl = Lgc[63];
        const float eg = __expf(gc), egl = __expf(gl - gc);
        auto conv = [&](int ten, float (&y)[16]) {
#pragma unroll
            for (int e = 0; e < 16; ++e) y[e] = 0.f;
#pragma unroll
            for (int j = 0; j < 4; ++j) {
                const LAS char* rp = lds + DL_RAW + (i + j) * 784 + (ten * 128 + 16 * part) * 2;
                const u32x4 d0 = *(const LAS u32x4*)rp, d1 = *(const LAS u32x4*)(rp + 16);
                const LAS float* wj = (const LAS float*)(lds + DL_CW) + j * 384 + ten * 128 + 16 * part;
#pragma unroll
                for (int e4 = 0; e4 < 4; ++e4) {
                    const f32x4 w = *(const LAS f32x4*)(wj + 4 * e4);
                    const unsigned lo = e4 < 2 ? d0[2 * e4] : d1[2 * e4 - 4], hi = e4 < 2 ? d0[2 * e4 + 1] : d1[2 * e4 - 3];
                    y[4 * e4 + 0] += w.x * bf2f(lo & 0xffff); y[4 * e4 + 1] += w.y * bf2f(lo >> 16);
                    y[4 * e4 + 2] += w.z * bf2f(hi & 0xffff); y[4 * e4 + 3] += w.w * bf2f(hi >> 16);
                }
            }
#pragma unroll
            for (int e = 0; e < 16; ++e) y[e] = silu_f(y[e]);
        };
        {
            if (zown) {
                unsigned po[8];
#pragma unroll
                for (int e = 0; e < 8; ++e) {
                    const unsigned zz = e < 4 ? z0[e] : z1[e - 4];
                    const float za = bf2f(zz & 0xffff), zb = bf2f(zz >> 16);
                    po[e] = pk2(ngv[e >> 1][(2 * e) & 3] * silu_f(za), ngv[e >> 1][(2 * e + 1) & 3] * silu_f(zb));
                }
                *(u32x4*)zp = (u32x4){po[0], po[1], po[2], po[3]}; *(u32x4*)(zp + 8) = (u32x4){po[4], po[5], po[6], po[7]};
            }
        }
        {
            float y[16]; conv(2, y);
#pragma unroll
            for (int e = 0; e < 16; ++e) *(LAS bf16_t*)(lds + DL_VBT + (16 * part + e) * 144 + ((((i >> 3) ^ part) & 7) << 4) + (i & 7) * 2) = (bf16_t)f2bf(y[e] * beta);
        }
        {
            float y[16]; conv(0, y);
            float sq = 0.f;
#pragma unroll
            for (int e = 0; e < 16; ++e) sq += y[e] * y[e];
            sq = sum8_dpp(sq);
            const float rq = rsqrtf(sq + 1e-6f) * 0.08838834764831845f;
            unsigned pq[8], pqd[8];
#pragma unroll
            for (int e = 0; e < 8; ++e) { const float q0 = y[2 * e] * rq, q1 = y[2 * e + 1] * rq; pq[e] = pk2(q0, q1); pqd[e] = pk2(q0 * eg, q1 * eg); }
            *(LAS u32x4*)(lds + DL_QS + i * 272 + part * 32) = (u32x4){pq[0], pq[1], pq[2], pq[3]}; *(LAS u32x4*)(lds + DL_QS + i * 272 + part * 32 + 16) = (u32x4){pq[4], pq[5], pq[6], pq[7]};
            bf16_t* QD = (bf16_t*)(ib + DN_QD) + i * 128 + part * 16;
            *(u32x4*)QD = (u32x4){pqd[0], pqd[1], pqd[2], pqd[3]}; *(u32x4*)(QD + 8) = (u32x4){pqd[4], pqd[5], pqd[6], pqd[7]};
        }
        {
            float y[16]; conv(1, y);
            float sk = 0.f;
#pragma unroll
            for (int e = 0; e < 16; ++e) sk += y[e] * y[e];
            sk = sum8_dpp(sk);
            const float rk = rsqrtf(sk + 1e-6f);
            unsigned pk[8], pkb[8];
#pragma unroll
            for (int e = 0; e < 8; ++e) { const float k0 = y[2 * e] * rk, k1 = y[2 * e + 1] * rk; pk[e] = pk2(k0, k1); pkb[e] = pk2(k0 * beta, k1 * beta); }
            *(LAS u32x4*)(lds + DL_KN + i * 272 + part * 32) = (u32x4){pk[0], pk[1], pk[2], pk[3]}; *(LAS u32x4*)(lds + DL_KN + i * 272 + part * 32 + 16) = (u32x4){pk[4], pk[5], pk[6], pk[7]};
            *(LAS u32x4*)(lds + DL_KB + i * 272 + part * 32) = (u32x4){pkb[0], pkb[1], pkb[2], pkb[3]}; *(LAS u32x4*)(lds + DL_KB + i * 272 + part * 32 + 16) = (u32x4){pkb[4], pkb[5], pkb[6], pkb[7]};
            bf16_t* KDT = (bf16_t*)(ib + DN_KDT);
#pragma unroll
            for (int e = 0; e < 16; ++e) {
                const int c = 16 * part + e; const float kn = y[e] * rk;
                *(LAS bf16_t*)(lds + DL_KBDT + c * 144 + ((((i >> 3) ^ part) & 7) << 4) + (i & 7) * 2) = (bf16_t)f2bf(kn * beta * eg);
                KDT[c * 64 + i] = (bf16_t)f2bf(kn * egl);
            }
        }
    }
    __syncthreads();
    {
        const int mat = wid >> 2, mb = (wid >> 1) & 1, nb = wid & 1;
        f32x16 acc;
#pragma unroll
        for (int r = 0; r < 16; ++r) acc[r] = 0.f;
        if (mb >= nb) {
            LAS char* ab = lds + (mat ? DL_QS : DL_KB) + (32 * mb + r32) * 272 + 16 * hh; LAS char* bb = lds + DL_KN + (32 * nb + r32) * 272 + 16 * hh;
#pragma unroll
            for (int s = 0; s < 8; ++s) acc = __builtin_amdgcn_mfma_f32_32x32x16_bf16(*(const LAS bf16x8*)(bb + 32 * s), *(const LAS bf16x8*)(ab + 32 * s), acc, 0, 0, 0);
        }
        const int i = 32 * mb + r32; const float gi = Lgc[i];
#pragma unroll
        for (int g = 0; g < 4; ++g) {
            const int j0 = 32 * nb + 8 * g + 4 * hh; const f32x4 gj = *(const LAS f32x4*)(Lgc + j0);
            float v[4];
#pragma unroll
            for (int jj = 0; jj < 4; ++jj) { const int j = j0 + jj; const bool keep = mat ? (i >= j) : (i > j); v[jj] = keep ? acc[4 * g + jj] * __expf(gi - gj[jj]) : 0.f; }
            if (mat == 0) *(LAS f32x4*)(lds + DL_A + i * 272 + j0 * 4) = (f32x4){v[0], v[1], v[2], v[3]};
            else { u32x2 o; o.x = pk2(v[0], v[1]); o.y = pk2(v[2], v[3]); *(u32x2*)((bf16_t*)(ib + DN_AQK) + i * 64 + j0) = o; }
        }
    }
    __syncthreads();
    {
        const LAS float* A = (const LAS float*)(lds + DL_A); LAS float* TF = (LAS float*)(lds + DL_TF);
        LAS float* XT = (LAS float*)(lds + DL_THI);
        if (wid == 0) {
            const int blk = lane >> 4, c = lane & 15;
            f32x4 ad[16][4];
#pragma unroll
            for (int ii = 1; ii < 16; ++ii)
#pragma unroll
                for (int c4 = 0; c4 < 4; ++c4) if (4 * c4 < ii) ad[ii][c4] = *(const LAS f32x4*)(A + (16 * blk + ii) * 68 + 16 * blk + 4 * c4);
            float t[16];
#pragma unroll
            for (int ii = 0; ii < 16; ++ii) {
                float acc = (c == ii) ? 1.f : 0.f;
#pragma unroll
                for (int jj = 0; jj < ii; ++jj) acc -= ad[ii][jj >> 2][jj & 3] * t[jj];
                t[ii] = acc;
            }
#pragma unroll
            for (int ii = 0; ii < 16; ++ii) TF[(16 * blk + ii) * 68 + 16 * blk + c] = t[ii];
        }
        __syncthreads();
#define BLK(M, i, j) ((M) + (16 * (i)) * 68 + 16 * (j))
        if (wid < 3) { float c[4] = {0.f, 0.f, 0.f, 0.f}; mm16_acc(c, BLK(A, wid + 1, wid), 68, BLK(TF, wid, wid), 68, lane); mm16_store(c, 1.f, XT + wid * 320, 20, lane); }
        __syncthreads();
        if (wid < 3) { float c[4] = {0.f, 0.f, 0.f, 0.f}; mm16_acc(c, BLK(TF, wid + 1, wid + 1), 68, XT + wid * 320, 20, lane); mm16_store(c, -1.f, BLK(TF, wid + 1, wid), 68, lane); }
        __syncthreads();
        if (wid < 2) { float c[4] = {0.f, 0.f, 0.f, 0.f}; mm16_acc(c, BLK(A, wid + 2, wid), 68, BLK(TF, wid, wid), 68, lane); mm16_acc(c, BLK(A, wid + 2, wid + 1), 68, BLK(TF, wid + 1, wid), 68, lane); mm16_store(c, 1.f, XT + wid * 320, 20, lane); }
        __syncthreads();
        if (wid < 2) { float c[4] = {0.f, 0.f, 0.f, 0.f}; mm16_acc(c, BLK(TF, wid + 2, wid + 2), 68, XT + wid * 320, 20, lane); mm16_store(c, -1.f, BLK(TF, wid + 2, wid), 68, lane); }
        __syncthreads();
        if (wid == 0) { float c[4] = {0.f, 0.f, 0.f, 0.f}; mm16_acc(c, BLK(A, 3, 0), 68, BLK(TF, 0, 0), 68, lane); mm16_acc(c, BLK(A, 3, 1), 68, BLK(TF, 1, 0), 68, lane); mm16_acc(c, BLK(A, 3, 2), 68, BLK(TF, 2, 0), 68, lane); mm16_store(c, 1.f, XT, 20, lane); }
        __syncthreads();
        if (wid == 0) { float c[4] = {0.f, 0.f, 0.f, 0.f}; mm16_acc(c, BLK(TF, 3, 3), 68, XT, 20, lane); mm16_store(c, -1.f, BLK(TF, 3, 0), 68, lane); }
#undef BLK
    }
    __syncthreads();
    {
        const int i = tid >> 3, c0 = (tid & 7) * 8;
        const f32x4 a = *(const LAS f32x4*)(lds + DL_TF + (i * 68 + c0) * 4), c = *(const LAS f32x4*)(lds + DL_TF + (i * 68 + c0 + 4) * 4);
        const bool up = (c0 >> 4) > (i >> 4);
        const float v[8] = {up ? 0.f : a.x, up ? 0.f : a.y, up ? 0.f : a.z, up ? 0.f : a.w, up ? 0.f : c.x, up ? 0.f : c.y, up ? 0.f : c.z, up ? 0.f : c.w};
        unsigned hi[8]; float lo[8];
#pragma unroll
        for (int e = 0; e < 8; ++e) { hi[e] = f2bf(v[e]); lo[e] = v[e] - bf2f((unsigned short)hi[e]); }
        *(LAS u32x4*)(lds + DL_THI + i * 144 + c0 * 2) = (u32x4){hi[0] | (hi[1] << 16), hi[2] | (hi[3] << 16), hi[4] | (hi[5] << 16), hi[6] | (hi[7] << 16)};
        *(LAS u32x4*)(lds + DL_TLO + i * 144 + c0 * 2) = (u32x4){pk2(lo[0], lo[1]), pk2(lo[2], lo[3]), pk2(lo[4], lo[5]), pk2(lo[6], lo[7])};
    }
    __syncthreads();
    {
        const int mb = wid >> 2, nb = wid & 3;
        LAS char* th = lds + DL_THI + (32 * mb + r32) * 144 + 16 * hh; LAS char* tl = lds + DL_TLO + (32 * mb + r32) * 144 + 16 * hh;
        LAS char* vb = lds + DL_VBT + (32 * nb + r32) * 144; LAS char* kb = lds + DL_KBDT + (32 * nb + r32) * 144;
        const int cx = (2 * nb + (r32 >> 4)) & 7;
        f32x16 u, w;
#pragma unroll
        for (int r = 0; r < 16; ++r) { u[r] = 0.f; w[r] = 0.f; }
#pragma unroll
        for (int s = 0; s < 4; ++s) {
            const bf16x8 ah = *(const LAS bf16x8*)(th + 32 * s), al = *(const LAS bf16x8*)(tl + 32 * s), bv = *(const LAS bf16x8*)(vb + (((2 * s + hh) ^ cx) << 4)), bk = *(const LAS bf16x8*)(kb + (((2 * s + hh) ^ cx) << 4));
            u = __builtin_amdgcn_mfma_f32_32x32x16_bf16(ah, bv, u, 0, 0, 0); u = __builtin_amdgcn_mfma_f32_32x32x16_bf16(al, bv, u, 0, 0, 0);
            w = __builtin_amdgcn_mfma_f32_32x32x16_bf16(bk, ah, w, 0, 0, 0); w = __builtin_amdgcn_mfma_f32_32x32x16_bf16(bk, al, w, 0, 0, 0);
        }
        unsigned pu[8];
#pragma unroll
        for (int e = 0; e < 8; ++e) pu[e] = pk2(u[2 * e], u[2 * e + 1]);
        bf16_t* U = (bf16_t*)(ib + DN_U) + ((mb * 4 + nb) * 64 + lane) * 16;
        *(u32x4*)U = (u32x4){pu[0], pu[1], pu[2], pu[3]}; *(u32x4*)(U + 8) = (u32x4){pu[4], pu[5], pu[6], pu[7]};
        bf16_t* W = (bf16_t*)(ib + DN_W) + (32 * mb + r32) * 128 + 32 * nb + 4 * hh;
#pragma unroll
        for (int g = 0; g < 4; ++g) { u32x2 o; o.x = pk2(-w[4 * g], -w[4 * g + 1]); o.y = pk2(-w[4 * g + 2], -w[4 * g + 3]); *(u32x2*)(W + 8 * g) = o; }
    }
    __syncthreads();
}

constexpr int SL_ST = 0, SL_VNT = 34816, SL_O = 53248, SL_WB = 87040, SL_QDB = 104448, SL_KDTB = 121856, SL_AQKB = 140288;
__device__ __forceinline__ void dn_scan(const Params& p, int l, int b, int h, LAS char* lds) {
    const int tid = otid(), lane = tid & 63, wid = tid >> 6, r32 = lane & 31, hh = lane >> 5;
    for (int i = tid; i < 34816 / 4; i += NTHREADS) ((LAS unsigned*)(lds + SL_ST))[i] = 0u;
    f32x16 S[2];
#pragma unroll
    for (int r = 0; r < 16; ++r) { S[0][r] = 0.f; S[1][r] = 0.f; }
    const int mb = wid >> 2, nb = wid & 3;
    const int vb = wid & 3, kb2 = wid >> 2;
    const bf16_t* PROJ = (const bf16_t*)(p.ws + WS_PROJ);
    const float* ng = inptr(p, I_DNG) + l * 128;
    const int ni = tid >> 3, npart = tid & 7;
    struct PfSet { u32x4 w[2], q[2], k[2], a, u[2]; float g; };
    PfSet s0, s1; u32x4 zn0, zn1;
    auto gload = [&](PfSet& r, int n) {
        const int item = (b * 4 + h) * 33 + n;
        const unsigned char* ib = p.ws + WS_X + (size_t)item * DN_ITEM_BYTES;
#pragma unroll
        for (int i = 0; i < 2; ++i) {
            const int pi = tid + 512 * i;
            r.w[i] = *(const u32x4*)(ib + DN_W + (pi >> 4) * 256 + (pi & 15) * 16);
            r.q[i] = *(const u32x4*)(ib + DN_QD + (pi >> 4) * 256 + (pi & 15) * 16);
            r.k[i] = *(const u32x4*)(ib + DN_KDT + (pi >> 3) * 128 + (pi & 7) * 16);
        }
        r.a = *(const u32x4*)(ib + DN_AQK + (tid >> 3) * 128 + (tid & 7) * 16);
        const bf16_t* U = (const bf16_t*)(ib + DN_U) + ((mb * 4 + nb) * 64 + lane) * 16;
        r.u[0] = *(const u32x4*)U; r.u[1] = *(const u32x4*)(U + 8);
        r.g = ((const float*)(p.ws + WS_GL))[item];
    };
    auto zload = [&](int n) {
        const int t = (n == 0) ? ni - 48 : NMETA + 64 * (n - 1) + ni;
        const bf16_t* zp = PROJ + (size_t)tok_row(b, t < 0 ? 0 : t) * 4096 + 1536 + h * 128 + 16 * npart;
        zn0 = *(const u32x4*)zp; zn1 = *(const u32x4*)(zp + 8);
    };
    auto lwrite = [&](const PfSet& r) {
#pragma unroll
        for (int i = 0; i < 2; ++i) {
            const int pi = tid + 512 * i;
            *(LAS u32x4*)(lds + SL_WB + (pi >> 4) * 272 + (pi & 15) * 16) = r.w[i];
            *(LAS u32x4*)(lds + SL_QDB + (pi >> 4) * 272 + (pi & 15) * 16) = r.q[i];
            *(LAS u32x4*)(lds + SL_KDTB + (pi >> 3) * 144 + (pi & 7) * 16) = r.k[i];
        }
        *(LAS u32x4*)(lds + SL_AQKB + (tid >> 3) * 144 + (tid & 7) * 16) = r.a;
    };
    gload(s0, 0); zload(0); lwrite(s0);
    u32x4 cU0 = s0.u[0], cU1 = s0.u[1], cZ0 = zn0, cZ1 = zn1; float cG = s0.g;
    __syncthreads();
    auto chunk = [&](int n, PfSet& fr, PfSet& nx) {
        const bool more = n + 1 < 33;
        if (more) { gload(nx, n + 1); zload(n + 1); }
        const float egl = __expf(cG);
        bf16x8 sf[8];
        {
            LAS char* sp = lds + SL_ST + (32 * nb + r32) * 272 + 16 * hh;
#pragma unroll
            for (int s = 0; s < 8; ++s) sf[s] = *(const LAS bf16x8*)(sp + 32 * s);
            f32x16 vn;
#pragma unroll
            for (int e = 0; e < 4; ++e) { vn[2 * e] = bf2f(cU0[e] & 0xffff); vn[2 * e + 1] = bf2f(cU0[e] >> 16); vn[8 + 2 * e] = bf2f(cU1[e] & 0xffff); vn[8 + 2 * e + 1] = bf2f(cU1[e] >> 16); }
            LAS char* wp = lds + SL_WB + (32 * mb + r32) * 272 + 16 * hh;
#pragma unroll
            for (int s = 0; s < 8; ++s) vn = __builtin_amdgcn_mfma_f32_32x32x16_bf16(*(const LAS bf16x8*)(wp + 32 * s), sf[s], vn, 0, 0, 0);
#pragma unroll
            for (int g = 0; g < 4; ++g) { u32x2 o; o.x = pk2(vn[4 * g], vn[4 * g + 1]); o.y = pk2(vn[4 * g + 2], vn[4 * g + 3]); *(LAS u32x2*)(lds + SL_VNT + (32 * nb + r32) * 144 + (32 * mb + 8 * g + 4 * hh) * 2) = o; }
        }
        __syncthreads();
        {
            f32x16 o;
#pragma unroll
            for (int r = 0; r < 16; ++r) o[r] = 0.f;
            LAS char* qp = lds + SL_QDB + (32 * mb + r32) * 272 + 16 * hh;
#pragma unroll
            for (int s = 0; s < 8; ++s) o = __builtin_amdgcn_mfma_f32_32x32x16_bf16(*(const LAS bf16x8*)(qp + 32 * s), sf[s], o, 0, 0, 0);
            LAS char* ap = lds + SL_AQKB + (32 * mb + r32) * 144 + 16 * hh;
            LAS char* vp = lds + SL_VNT + (32 * nb + r32) * 144 + 16 * hh;
#pragma unroll
            for (int s = 0; s < 4; ++s) o = __builtin_amdgcn_mfma_f32_32x32x16_bf16(*(const LAS bf16x8*)(ap + 32 * s), *(const LAS bf16x8*)(vp + 32 * s), o, 0, 0, 0);
#pragma unroll
            for (int r = 0; r < 16; ++r) *(LAS float*)(lds + SL_O + ((32 * mb + (r & 3) + 8 * (r >> 2) + 4 * hh) * 132 + 32 * nb + r32) * 4) = o[r];
            LAS char* vp4 = lds + SL_VNT + (32 * vb + r32) * 144 + 16 * hh;
            bf16x8 vf[4];
#pragma unroll
            for (int s = 0; s < 4; ++s) vf[s] = *(const LAS bf16x8*)(vp4 + 32 * s);
#pragma unroll
            for (int q = 0; q < 2; ++q) {
                LAS char* kp = lds + SL_KDTB + (32 * (2 * kb2 + q) + r32) * 144 + 16 * hh;
                S[q] = S[q] * egl;
#pragma unroll
                for (int s = 0; s < 4; ++s) S[q] = __builtin_amdgcn_mfma_f32_32x32x16_bf16(*(const LAS bf16x8*)(kp + 32 * s), vf[s], S[q], 0, 0, 0);
            }
        }
        __syncthreads();
#pragma unroll
        for (int q = 0; q < 2; ++q)
#pragma unroll
            for (int g = 0; g < 4; ++g) { u32x2 o; o.x = pk2(S[q][4 * g], S[q][4 * g + 1]); o.y = pk2(S[q][4 * g + 2], S[q][4 * g + 3]); *(LAS u32x2*)(lds + SL_ST + (32 * vb + r32) * 272 + (32 * (2 * kb2 + q) + 8 * g + 4 * hh) * 2) = o; }
        {
            const int t = (n == 0) ? ni - 48 : NMETA + 64 * (n - 1) + ni;
            float ov[16]; float ss = 0.f;
#pragma unroll
            for (int e4 = 0; e4 < 4; ++e4) { const f32x4 v4 = *(const LAS f32x4*)(lds + SL_O + (ni * 132 + 16 * npart + 4 * e4) * 4); ov[4 * e4] = v4.x; ov[4 * e4 + 1] = v4.y; ov[4 * e4 + 2] = v4.z; ov[4 * e4 + 3] = v4.w; ss += v4.x * v4.x + v4.y * v4.y + v4.z * v4.z + v4.w * v4.w; }
            ss = sum8_dpp(ss);
            if (t >= 0 && (n > 0 || b == 0)) {
                const float rms = rsqrtf(ss * (1.f / 128.f) + 1e-6f);
                unsigned po[8];
#pragma unroll
                for (int e = 0; e < 8; ++e) {
                    const unsigned zz = e < 4 ? cZ0[e] : cZ1[e - 4];
                    po[e] = pk2(ov[2 * e] * rms * bf2f(zz & 0xffff), ov[2 * e + 1] * rms * bf2f(zz >> 16));
                }
                bf16_t* mp = mix_row(p, tok_row(b, t)) + h * 128 + 16 * npart;
                *(u32x4*)mp = (u32x4){po[0], po[1], po[2], po[3]}; *(u32x4*)(mp + 8) = (u32x4){po[4], po[5], po[6], po[7]};
            }
        }
        if (more) { lwrite(nx); cU0 = nx.u[0]; cU1 = nx.u[1]; cZ0 = zn0; cZ1 = zn1; cG = nx.g; }
        __syncthreads();
    };
    for (int n = 0; n < 33; ++n) chunk(n, s0, s0);
}

__device__ __forceinline__ int queue_pop(unsigned* ctr, LAS char* lds) {
    LAS int* slot = (LAS int*)(lds + LDS_BYTES - 16);
    __syncthreads();
    if (threadIdx.x == 0) *slot = (int)atomicAdd(ctr, 1u);
    __syncthreads();
    return *slot;
}


__device__ __forceinline__ int wave_sum_dpp(int v) {
    v += __builtin_amdgcn_mov_dpp(v, 0xB1, 0xf, 0xf, true);
    v += __builtin_amdgcn_mov_dpp(v, 0x4E, 0xf, 0xf, true);
    v += __builtin_amdgcn_mov_dpp(v, 0x141, 0xf, 0xf, true);
    v += __builtin_amdgcn_mov_dpp(v, 0x140, 0xf, 0xf, true);
    return __builtin_amdgcn_readlane(v, 0) + __builtin_amdgcn_readlane(v, 16) + __builtin_amdgcn_readlane(v, 32) + __builtin_amdgcn_readlane(v, 48);
}

__device__ __forceinline__ unsigned pk_gt1(unsigned keys, unsigned cm1, unsigned one2) {
    unsigned t, r;
    asm("v_pk_sub_u16 %0, %1, %2 clamp" : "=v"(t) : "v"(keys), "v"(cm1));
    asm("v_pk_min_u16 %0, %1, %2" : "=v"(r) : "v"(t), "v"(one2));
    return r;
}
__device__ __forceinline__ unsigned pk_add(unsigned a, unsigned b) { unsigned r; asm("v_pk_add_u16 %0, %1, %2" : "=v"(r) : "v"(a), "v"(b)); return r; }
__device__ __forceinline__ unsigned pk_count17(const unsigned (&pk)[17], unsigned cm1, unsigned one2) {
    unsigned t[17];
#pragma unroll
    for (int k = 0; k < 17; ++k) t[k] = pk_gt1(pk[k], cm1, one2);
#pragma unroll
    for (int k = 0; k < 8; ++k) t[k] = pk_add(t[k], t[k + 8]);
#pragma unroll
    for (int k = 0; k < 4; ++k) t[k] = pk_add(t[k], t[k + 4]);
    t[0] = pk_add(pk_add(t[0], t[1]), pk_add(t[2], t[3]));
    return pk_add(t[0], t[16]);
}
__device__ __forceinline__ unsigned pk_pair_sum(unsigned na, unsigned nb) {
    return pk_add(__builtin_amdgcn_perm(nb, na, 0x05040100u), __builtin_amdgcn_perm(nb, na, 0x07060302u));
}
constexpr int CW_IDXF = 8192;
constexpr int IDX_SPLIT = 96;
constexpr int QUEUE_TAIL = 320;
constexpr int SC_PITCH = 2084;
__device__ __forceinline__ void idx_unit(const Params& p, int u, LAS char* lds, unsigned* qctr, bool claim, int& nxt) {
    const int tid = otid(), lane = tid & 63, wid = tid >> 6, r32 = lane & 31, hh = lane >> 5;
    const int b = u & 7, qb = 127 - (u >> 3);
    const int t0 = NMETA + 16 * qb, NK = t0 + 16, nkb = (NK + 31) >> 5;
    const bf16_t* PROJ = (const bf16_t*)(p.ws + WS_PROJ); const bf16_t* IK = (const bf16_t*)(p.ws + WS_IK); const float* PX = (const float*)(p.ws + WS_PX);
    unsigned* MASK = (unsigned*)(p.ws + WS_MASK);
    LAS float* SC = (LAS float*)lds;
    {
        typedef float f32x4v __attribute__((ext_vector_type(4)));
        const int q16 = lane & 15, kq = lane >> 4;
        const int qrow = b * SEQ + 16 * qb + q16;
        const int nkb16 = (NK + 15) >> 4;
        bf16x8 kf[2], kn[2], kn2[2];
        auto kload = [&](bf16x8 (&dst)[2], int kb_) {
            int tk = 16 * kb_ + q16; tk = tk < LT ? tk : LT - 1;
            const bf16_t* kp = IK + (size_t)tok_row(b, tk) * 64 + 8 * kq;
            dst[0] = *(const bf16x8*)kp; dst[1] = *(const bf16x8*)(kp + 32);
        };
        kload(kn, wid);
        bf16x8 qf[8][2]; float wq[8];
#pragma unroll
        for (int hd = 0; hd < 8; ++hd) {
#pragma unroll
            for (int s = 0; s < 2; ++s) qf[hd][s] = *(const bf16x8*)(PROJ + (size_t)qrow * 4096 + 3584 + hd * 64 + 32 * s + 8 * kq);
            wq[hd] = PX[(size_t)qrow * 16 + 8 + hd] * (0.125f * 0.35355339059327373f);
        }
        kload(kn2, wid + 8);
        for (int kb = wid; kb < nkb16; kb += 8) {
#pragma unroll
            for (int s = 0; s < 2; ++s) { kf[s] = kn[s]; kn[s] = kn2[s]; }
            kload(kn2, kb + 16);
            f32x4v sc = (f32x4v){0.f, 0.f, 0.f, 0.f};
#pragma unroll
            for (int hd = 0; hd < 8; ++hd) {
                f32x4v d = __builtin_amdgcn_mfma_f32_16x16x32_bf16(kf[0], qf[hd][0], (f32x4v){0.f, 0.f, 0.f, 0.f}, 0, 0, 0);
                d = __builtin_amdgcn_mfma_f32_16x16x32_bf16(kf[1], qf[hd][1], d, 0, 0, 0);
#pragma unroll
                for (int r = 0; r < 4; ++r) sc[r] += wq[hd] * fmaxf(d[r], 0.f);
            }
            *(LAS f32x4*)(SC + q16 * SC_PITCH + 16 * kb + 4 * kq) = (f32x4){sc[0], sc[1], sc[2], sc[3]};
        }
    }
    __syncthreads();
    if (claim && tid == 0) { unsigned zoff = 0u; asm volatile("" : "+v"(zoff)); nxt = (int)__hip_atomic_fetch_add(qctr + zoff, 1u, __ATOMIC_RELAXED, __HIP_MEMORY_SCOPE_AGENT); }
    {
        const int qa = 2 * wid, tqa = t0 + qa, tqb = tqa + 1;
        unsigned ua[33], ub[33];
#pragma unroll
        for (int j = 0; j < 33; ++j) {
            const int key = 64 * j + lane;
            float fa = (key <= tqa) ? SC[qa * SC_PITCH + key] : 0.f, fb = (key <= tqb) ? SC[(qa + 1) * SC_PITCH + key] : 0.f;
            fa += 0.f; fb += 0.f;
            const unsigned ba = __builtin_bit_cast(unsigned, fa), bb = __builtin_bit_cast(unsigned, fb);
            ua[j] = (key <= tqa) ? (ba ^ ((ba >> 31) ? 0xffffffffu : 0x80000000u)) : 0u;
            ub[j] = (key <= tqb) ? (bb ^ ((bb >> 31) ? 0xffffffffu : 0x80000000u)) : 0u;
        }
        unsigned one2 = 0x00010001u; asm volatile("" : "+v"(one2));
        unsigned pa[17], pb[17];
#pragma unroll
        for (int k = 0; k < 17; ++k) {
            pa[k] = (ua[2 * k] >> 16) | (k < 16 ? (ua[2 * k + 1] & 0xffff0000u) : 0u);
            pb[k] = (ub[2 * k] >> 16) | (k < 16 ? (ub[2 * k + 1] & 0xffff0000u) : 0u);
        }
        unsigned thra = 0u, thrb = 0u;
        bool acta = tqa + 1 > 256, actb = tqb + 1 > 256;
        bool p2a = acta, p2b = actb;
        for (int bit = 15; bit >= 0 && (acta || actb); --bit) {
            const unsigned ca = (thra | (1u << bit)) - 1u, cb = (thrb | (1u << bit)) - 1u;
            const unsigned ca2 = ca * 0x00010001u, cb2 = cb * 0x00010001u;
            const unsigned na = pk_count17(pa, ca2, one2), nb = pk_count17(pb, cb2, one2);
            const int tt = wave_sum_dpp((int)pk_pair_sum(na, nb)), ta = tt & 0xffff, tb = (int)((unsigned)tt >> 16);
            if (acta) { if (ta >= 256) thra = ca + 1u; if (ta == 256) { acta = false; p2a = false; } }
            if (actb) { if (tb >= 256) thrb = cb + 1u; if (tb == 256) { actb = false; p2b = false; } }
        }
        int wanta = 0, wantb = 0;
        {
            const unsigned ha = thra * 0x00010001u, hb = thrb * 0x00010001u;
            const unsigned ga = pk_count17(pa, ha, one2), gb = pk_count17(pb, hb, one2);
            const int gg = wave_sum_dpp((int)pk_pair_sum(ga, gb));
            wanta = 256 - (gg & 0xffff); wantb = 256 - (int)((unsigned)gg >> 16);
#pragma unroll
            for (int k = 0; k < 17; ++k) {
                const unsigned a0 = ua[2 * k], a1 = k < 16 ? ua[2 * k + 1] : 0u, b0 = ub[2 * k], b1 = k < 16 ? ub[2 * k + 1] : 0u;
                pa[k] = ((a0 >> 16) == thra ? (a0 & 0xffffu) : 0u) | ((a1 >> 16) == thra ? (a1 << 16) : 0u);
                pb[k] = ((b0 >> 16) == thrb ? (b0 & 0xffffu) : 0u) | ((b1 >> 16) == thrb ? (b1 << 16) : 0u);
            }
        }
        unsigned lowa = 0u, lowb = 0u;
        int c2a = -1, c2b = -1;
        acta = p2a; actb = p2b;
        for (int bit = 15; bit >= 0 && (acta || actb); --bit) {
            const unsigned ca = (lowa | (1u << bit)) - 1u, cb = (lowb | (1u << bit)) - 1u;
            const unsigned ca2 = ca * 0x00010001u, cb2 = cb * 0x00010001u;
            const unsigned na = pk_count17(pa, ca2, one2), nb = pk_count17(pb, cb2, one2);
            const int tt = wave_sum_dpp((int)pk_pair_sum(na, nb)), ta = tt & 0xffff, tb = (int)((unsigned)tt >> 16);
            if (acta) { if (ta >= wanta) { lowa = ca + 1u; c2a = ta; } if (ta == wanta) acta = false; }
            if (actb) { if (tb >= wantb) { lowb = cb + 1u; c2b = tb; } if (tb == wantb) actb = false; }
        }
        thra = (thra << 16) | lowa; thrb = (thrb << 16) | lowb;
        const bool exa = !p2a || c2a == wanta, exb = !p2b || c2b == wantb;
#pragma unroll
        for (int qq = 0; qq < 2; ++qq) {
            const int n = (qq ? tqb : tqa) + 1; const unsigned thr = qq ? thrb : thra;
            unsigned* mrow = MASK + (size_t)(b * SEQ + 16 * qb + qa + qq) * MASKW;
            const bool simple = (n <= 256) || (qq ? exb : exa);
            int run = 0;
            unsigned wlo = 0u, whi = 0u;
            if (simple) {
                const unsigned tcmp = (n <= 256) ? 1u : thr;
#pragma unroll
                for (int j = 0; j < 33; ++j) {
                    const unsigned long long w = __ballot((qq ? ub[j] : ua[j]) >= tcmp);
                    if (lane == j) { wlo = (unsigned)w; whi = (unsigned)(w >> 32); }
                }
            } else {
                int cg = 0;
#pragma unroll
                for (int j = 0; j < 33; ++j) cg += ((qq ? ub[j] : ua[j]) > thr) ? 1 : 0;
                const int need = 256 - wave_sum_dpp(cg);
#pragma unroll
                for (int j = 0; j < 33; ++j) {
                    const unsigned uv = qq ? ub[j] : ua[j];
                    const bool eq = uv == thr;
                    const unsigned long long beq = __ballot(eq);
                    const int rank = run + (int)__builtin_amdgcn_mbcnt_hi((unsigned)(beq >> 32), __builtin_amdgcn_mbcnt_lo((unsigned)beq, 0u));
                    const bool take = (uv > thr) || (eq && rank < need);
                    const unsigned long long w = __ballot(take);
                    run += __popcll(beq);
                    if (lane == j) { wlo = (unsigned)w; whi = (unsigned)(w >> 32); }
                }
            }
            if (lane < 34) __hip_atomic_store((unsigned long long*)(mrow + 2 * lane), ((unsigned long long)whi << 32) | wlo, __ATOMIC_RELAXED, __HIP_MEMORY_SCOPE_AGENT);
        }
    }
}
__device__ __forceinline__ void meta_mask_unit(const Params& p) {
    unsigned* MASK = (unsigned*)(p.ws + WS_MASK) + (size_t)NMAIN * MASKW;
    for (int i = otid(); i < NMETA * MASKW; i += NTHREADS) { const int t = i / MASKW, w = i % MASKW; MASK[i] = w == 0 ? ((2u << t) - 1u) : 0u; }
}

constexpr int AL_VT = 9216, AL_STG = 21504;
__device__ __forceinline__ void attn_unit(const Params& p, int l_, int item, LAS char* lds, unsigned* qctr, bool claim, int& nxt) {
    const int tid = otid(), lane = tid & 63, wid = tid >> 6, r32 = lane & 31, hh = lane >> 5;
    const bool meta = item >= 512;
    const int qblk = meta ? 0 : 7 - (item >> 6), b = meta ? 0 : (item & 63) >> 3, h = meta ? item - 512 : item & 7;
    if (!meta && (127 - 16 * qblk) * 8 + b >= IDX_SPLIT) {
        if (tid == 0) {
            unsigned* f = (unsigned*)(p.ws + WS_CTL) + CW_IDXF + l_ * 64 + b * 8 + qblk;
            unsigned sp = 0u;
            while (__hip_atomic_load(f, __ATOMIC_RELAXED, __HIP_MEMORY_SCOPE_AGENT) < 16u && ++sp < (1u << 22)) __builtin_amdgcn_s_sleep(2);
            __builtin_amdgcn_fence(__ATOMIC_ACQUIRE, "agent");
            asm volatile("s_waitcnt vmcnt(0)" ::: "memory");
        }
        __syncthreads();
    }
    const int qi = 32 * wid + r32;
    const bool qvalid = !meta || qi < NMETA;
    const int qrow = meta ? NMAIN + (qvalid ? qi : NMETA - 1) : b * SEQ + 256 * qblk + qi;
    const int ntiles = meta ? 1 : 4 * qblk + 5;
    const int wt_last = meta ? 0 : (NMETA + 256 * qblk + 32 * wid + 31) >> 6;
    const bf16_t* PROJ = (const bf16_t*)(p.ws + WS_PROJ);
    const unsigned* mrow = (const unsigned*)(p.ws + WS_MASK) + (size_t)qrow * MASKW;
    bf16x8 qf[4];
#pragma unroll
    for (int s = 0; s < 4; ++s) qf[s] = *(const bf16x8*)(PROJ + (size_t)qrow * 4096 + 2048 + h * 64 + 16 * s + 8 * hh);
    float m = -1e30f, l = 0.f; f32x16 o[2];
#pragma unroll
    for (int r = 0; r < 16; ++r) { o[0][r] = 0.f; o[1][r] = 0.f; }
    const int skey = tid >> 3, sch = tid & 7;
    u32x4 kreg, vreg;
    auto gload = [&](int j) {
        int tk = 64 * j + skey; tk = tk < LT ? tk : LT - 1;
        const bf16_t* rp = PROJ + (size_t)tok_row(b, tk) * 4096 + h * 64 + 8 * sch;
        kreg = *(const u32x4*)(rp + 2560); vreg = *(const u32x4*)(rp + 3072);
    };
    auto lwrite = [&](int st) {
        LAS char* sb = lds + st * AL_STG;
        *(LAS u32x4*)(sb + skey * 144 + sch * 16) = kreg;
        *(LAS u32x4*)(sb + AL_VT + skey * 192 + sch * 16) = vreg;
    };
    gload(0); lwrite(0);
    u32x2 mwn = *(const u32x2*)(mrow);
    __syncthreads();
    for (int j = 0; j < ntiles; ++j) {
        const bool more = j + 1 < ntiles;
        if (more) gload(j + 1);
        else if (claim && tid == 0) { unsigned zoff = 0u; asm volatile("" : "+v"(zoff)); nxt = (int)__hip_atomic_fetch_add(qctr + zoff, 1u, __ATOMIC_RELAXED, __HIP_MEMORY_SCOPE_AGENT); }
        const u32x2 mw = mwn;
        if (more) mwn = *(const u32x2*)(mrow + 2 * (j + 1));
        if (j <= wt_last) {
            const unsigned mw0 = qvalid ? mw.x : 0u, mw1 = qvalid ? mw.y : 0u;
            LAS char* sb = lds + (j & 1) * AL_STG;
            f32x16 p0, p1;
#pragma unroll
            for (int r = 0; r < 16; ++r) { p0[r] = 0.f; p1[r] = 0.f; }
#pragma unroll
            for (int s = 0; s < 4; ++s) {
                const bf16x8 k0 = *(const LAS bf16x8*)(sb + r32 * 144 + 32 * s + 16 * hh), k1 = *(const LAS bf16x8*)(sb + (32 + r32) * 144 + 32 * s + 16 * hh);
                p0 = __builtin_amdgcn_mfma_f32_32x32x16_bf16(k0, qf[s], p0, 0, 0, 0); p1 = __builtin_amdgcn_mfma_f32_32x32x16_bf16(k1, qf[s], p1, 0, 0, 0);
            }
            float tmax = -INFINITY;
#pragma unroll
            for (int r = 0; r < 16; ++r) {
                const int bit = (r & 3) + 8 * (r >> 2) + 4 * hh;
                p0[r] = ((mw0 >> bit) & 1u) ? p0[r] : -INFINITY; p1[r] = ((mw1 >> bit) & 1u) ? p1[r] : -INFINITY;
                tmax = fmaxf(tmax, fmaxf(p0[r], p1[r]));
            }
            { const unsigned tb_ = __builtin_bit_cast(unsigned, tmax); auto rr = __builtin_amdgcn_permlane32_swap(tb_, tb_, false, false); tmax = fmaxf(__builtin_bit_cast(float, (unsigned)rr[0]), __builtin_bit_cast(float, (unsigned)rr[1])); }
            const float mnew = (tmax > m + 8.f) ? tmax : m;
            if (__builtin_amdgcn_ballot_w64(mnew != m) != 0ull) {
                const float alpha = __builtin_amdgcn_exp2f(m - mnew);
                l = l * alpha; m = mnew;
                o[0] = o[0] * alpha; o[1] = o[1] * alpha;
            }
            float rs = 0.f;
#pragma unroll
            for (int r = 0; r < 16; ++r) { p0[r] = __builtin_amdgcn_exp2f(p0[r] - m); p1[r] = __builtin_amdgcn_exp2f(p1[r] - m); rs += p0[r] + p1[r]; }
            { const unsigned rb_ = __builtin_bit_cast(unsigned, rs); auto rr = __builtin_amdgcn_permlane32_swap(rb_, rb_, false, false); rs = __builtin_bit_cast(float, (unsigned)rr[0]) + __builtin_bit_cast(float, (unsigned)rr[1]); }
            l += rs;
#pragma unroll
            for (int blk = 0; blk < 2; ++blk)
#pragma unroll
                for (int s = 0; s < 2; ++s) {
                    u32x4 pw;
#pragma unroll
                    for (int e = 0; e < 4; ++e) pw[e] = blk ? pk2(p1[8 * s + 2 * e], p1[8 * s + 2 * e + 1]) : pk2(p0[8 * s + 2 * e], p0[8 * s + 2 * e + 1]);
                    const bf16x8 pf = __builtin_bit_cast(bf16x8, pw);
#pragma unroll
                    for (int db = 0; db < 2; ++db) {
                        LAS char* vp = sb + AL_VT + (32 * blk + 16 * s + 4 * hh + ((lane & 15) >> 2)) * 192 + (32 * db + (lane & 16) + 4 * (lane & 3)) * 2;
                        typedef short v4i16_t __attribute__((ext_vector_type(4)));
                        const v4i16_t va = __builtin_amdgcn_ds_read_tr16_b64_v4i16((LAS v4i16_t*)vp), vb = __builtin_amdgcn_ds_read_tr16_b64_v4i16((LAS v4i16_t*)(vp + 8 * 192));
                        const bf16x8 vf = (bf16x8){va[0], va[1], va[2], va[3], vb[0], vb[1], vb[2], vb[3]};
                        o[db] = __builtin_amdgcn_mfma_f32_32x32x16_bf16(vf, pf, o[db], 0, 0, 0);
                    }
                }
        }
        if (more) lwrite((j + 1) & 1);
        __syncthreads();
    }
    if (qvalid) {
        const float inv = 1.f / l;
        bf16_t* dst = mix_row(p, qrow) + 512 + h * 64 + 4 * hh;
#pragma unroll
        for (int db = 0; db < 2; ++db)
#pragma unroll
            for (int g = 0; g < 4; ++g) { u32x2 ov; ov.x = pk2(o[db][4 * g] * inv, o[db][4 * g + 1] * inv); ov.y = pk2(o[db][4 * g + 2] * inv, o[db][4 * g + 3] * inv); *(u32x2*)(dst + 32 * db + 8 * g) = ov; }
    }
}

__device__ __forceinline__ void phaseB(const Params& p, int l, bool second, int ph, LAS char* lds) {
    unsigned* ctr = (unsigned*)(p.ws + WS_CTL) + 16 + ph;
    if (second) { if (blockIdx.x < 32) dn_scan(p, l, blockIdx.x >> 2, blockIdx.x & 3, lds); }
    else if (blockIdx.x == gridDim.x - 1) meta_mask_unit(p);
    const int u0 = second ? IDX_SPLIT : 0, n_idx = second ? 1024 - IDX_SPLIT : IDX_SPLIT, n_tot = n_idx + (second ? 520 : 1056);
    LAS int* slot = (LAS int*)(lds + LDS_BYTES - 16);
    int it = queue_pop(ctr, lds);
    for (;;) {
        if (it >= n_tot) break;
        int nxt = -1;
        if (it < n_idx) {
            const int u = it + u0;
            idx_unit(p, u, lds, ctr, it < n_tot - QUEUE_TAIL, nxt);
            asm volatile("s_waitcnt vmcnt(0)" ::: "memory");
            __syncthreads();
            if (threadIdx.x == 0) __hip_atomic_fetch_add((unsigned*)(p.ws + WS_CTL) + CW_IDXF + l * 64 + (u & 7) * 8 + ((127 - (u >> 3)) >> 4), 1u, __ATOMIC_RELAXED, __HIP_MEMORY_SCOPE_AGENT);
        } else if (second) attn_unit(p, l, it - n_idx, lds, ctr, it < n_tot - QUEUE_TAIL, nxt);
        else dn_intra_item(p, l, it - n_idx, lds, ctr, it < n_tot - QUEUE_TAIL, nxt);
        __syncthreads();
        if (threadIdx.x == 0) *slot = nxt >= 0 ? nxt : (int)atomicAdd(ctr, 1u);
        __syncthreads();
        it = *slot;
    }
}

constexpr int CW_CNT = 256;

__device__ __forceinline__ void phaseD(const Params& p, int l, int nrows, LAS char* lds) {
    const int tid = otid(), lane = tid & 63, wid = tid >> 6;
    const int gw = blockIdx.x * 8 + wid, NGW = gridDim.x * 8;
    {
        LAS char* scr = lds + wid * 9216;
        const float* w1 = inptr(p, I_W1) + (size_t)l * NEXP * D * DEXP; const float* w3 = inptr(p, I_W3) + (size_t)l * NEXP * D * DEXP; const float* w2 = inptr(p, I_W2) + (size_t)l * NEXP * DEXP * D;
        for (int it = gw; it < NEXP * 192; it += NGW) {
            const int e = it / 192; int r = it % 192;
            if (r < 128) {
                const int isb = r >> 6, kb = (r >> 2) & 15, nb = r & 3;
                auto orow = [&](int f) -> int { return 64 * (f >> 5) + 32 * isb + (f & 31); };
                transpose_tile64((isb ? w3 : w1) + (size_t)e * D * DEXP, DEXP, kb * 64, nb * 64, (bf16_t*)(p.ws + WS_W13T) + (size_t)e * 512 * D, D, orow, scr, lane);
            } else {
                r -= 128; const int kb = r >> 4, nb = r & 15;
                auto orow = [&](int n) -> int { return n; };
                transpose_tile64(w2 + (size_t)e * DEXP * D, D, kb * 64, nb * 64, (bf16_t*)(p.ws + WS_W2T) + (size_t)e * D * DEXP, DEXP, orow, scr, lane);
            }
        }
    }
    __syncthreads();
    LAS float* Wl = (LAS float*)lds;
    LAS unsigned* lcnt = (LAS unsigned*)(lds + 147456);
    LAS unsigned* lbase = lcnt + 32;
    LAS unsigned* lent = lcnt + 64;
    {
        const f32x4* rw = (const f32x4*)(p.ws + WS_RW + (size_t)l * D * 36 * 4);
        {
            static_assert(D * 9 == 18 * NTHREADS, "router weight table");
#pragma unroll
            for (int hb_ = 0; hb_ < 2; ++hb_) {
                f32x4 t9[9];
#pragma unroll
                for (int k = 0; k < 9; ++k) t9[k] = rw[tid + (9 * hb_ + k) * NTHREADS];
#pragma unroll
                for (int k = 0; k < 9; ++k) *(LAS f32x4*)(lds + (tid + (9 * hb_ + k) * NTHREADS) * 16) = t9[k];
            }
        }
        if (tid < 32) lcnt[tid] = 0u;
        for (int idx = tid; idx < 8 * 10 * 2; idx += NTHREADS) lent[idx * 4] = 0xffffffffu;
    }
    __syncthreads();
    const float* g = inptr(p, I_LN1G) + l * D; const float* bb = inptr(p, I_LN1B) + l * D;
    const float* bg = inptr(p, I_BGRP) + l * 4; const float* br = inptr(p, I_BRTR) + l * 32;
    bf16_t* Hb = (bf16_t*)(p.ws + WS_BF);
    unsigned* cnt = (unsigned*)(p.ws + WS_CTL) + CW_CNT + l * 64;
    unsigned* list = (unsigned*)(p.ws + WS_LIST); float* listg = (float*)(p.ws + WS_LISTG);
    f32x4 gv[4], bv4[4];
#pragma unroll
    for (int j = 0; j < 4; ++j) { gv[j] = *(const f32x4*)(g + (lane + 64 * j) * 4); bv4[j] = *(const f32x4*)(bb + (lane + 64 * j) * 4); }
    const float bg0 = bg[0], bg1 = bg[1], bg2 = bg[2], bg3 = bg[3];
    LAS float* lbr = (LAS float*)(lcnt + 64 + 8 * 10 * 2 * 4);
    if (tid < 32) lbr[tid] = br[tid];
    __syncthreads();
    f32x4 wg[4][4];
#pragma unroll
    for (int j = 0; j < 4; ++j)
#pragma unroll
        for (int i = 0; i < 4; ++i) wg[j][i] = *(const LAS f32x4*)(Wl + ((j * 4 + i) * 64 + lane) * 36);
    int kr = 0;
    u32x2 vnx[4], hnx[4];
    if (gw < nrows) {
#pragma unroll
        for (int j = 0; j < 4; ++j) { vnx[j] = *(const u32x2*)(y1_row(p, gw) + (lane + 64 * j) * 4); hnx[j] = *(const u32x2*)(Hb + (size_t)gw * D + (lane + 64 * j) * 4); }
    }
    for (int row = gw; row < nrows; row += NGW, ++kr) {
        f32x4 v[4]; float s = 0.f;
#pragma unroll
        for (int j = 0; j < 4; ++j) { v[j] = bf4(hnx[j]) * ALPHA + bf4(vnx[j]); s += (v[j].x + v[j].y) + (v[j].z + v[j].w); }
        if (row + NGW < nrows) {
            const bf16_t* np_ = y1_row(p, row + NGW); const bf16_t* nh_ = Hb + (size_t)(row + NGW) * D;
#pragma unroll
            for (int j = 0; j < 4; ++j) { vnx[j] = *(const u32x2*)(np_ + (lane + 64 * j) * 4); hnx[j] = *(const u32x2*)(nh_ + (lane + 64 * j) * 4); }
        }
        const float mean = wave_sum(s) * (1.f / D); float s2 = 0.f;
#pragma unroll
        for (int j = 0; j < 4; ++j) { v[j] = v[j] - mean; s2 += (v[j].x * v[j].x + v[j].y * v[j].y) + (v[j].z * v[j].z + v[j].w * v[j].w); }
        const float rstd = 1.f / sqrtf(wave_sum(s2) * (1.f / D) + 1e-5f);
        f32x4 lg = (f32x4){0.f, 0.f, 0.f, 0.f};
#pragma unroll
        for (int j = 0; j < 4; ++j) {
            const f32x4 o = v[j] * rstd * gv[j] + bv4[j]; v[j] = o;
            u32x2 ob; ob.x = pk2(o.x, o.y); ob.y = pk2(o.z, o.w);
            *(u32x2*)(Hb + (size_t)row * D + (lane + 64 * j) * 4) = ob;
#pragma unroll
            for (int i = 0; i < 4; ++i) lg += wg[j][i] * o[i];
        }
        float l0 = wave_sum(lg.x) + bg0, l1 = wave_sum(lg.y) + bg1, l2 = wave_sum(lg.z) + bg2, l3 = wave_sum(lg.w) + bg3;
        int gsel = 0; float gm = l0;
        if (l1 > gm) { gm = l1; gsel = 1; }
        if (l2 > gm) { gm = l2; gsel = 2; }
        if (l3 > gm) { gm = l3; gsel = 3; }
        const float gprob = 1.f / (__expf(l0 - gm) + __expf(l1 - gm) + __expf(l2 - gm) + __expf(l3 - gm));
        gsel = __builtin_amdgcn_readfirstlane(gsel);
        f32x4 ea = (f32x4){0.f, 0.f, 0.f, 0.f}, eb = (f32x4){0.f, 0.f, 0.f, 0.f};
#pragma unroll
        for (int j = 0; j < 4; ++j)
#pragma unroll
            for (int i = 0; i < 4; ++i) {
                const LAS float* wp = Wl + ((j * 4 + i) * 64 + lane) * 36 + 4 + 8 * gsel;
                ea += *(const LAS f32x4*)(wp) * v[j][i]; eb += *(const LAS f32x4*)(wp + 4) * v[j][i];
            }
        float el[8];
        el[0] = wave_sum(ea.x); el[1] = wave_sum(ea.y); el[2] = wave_sum(ea.z); el[3] = wave_sum(ea.w);
        el[4] = wave_sum(eb.x); el[5] = wave_sum(eb.y); el[6] = wave_sum(eb.z); el[7] = wave_sum(eb.w);
#pragma unroll
        for (int i = 0; i < 8; ++i) el[i] += lbr[8 * gsel + i];
        int i0 = 0; float m0 = el[0];
#pragma unroll
        for (int i = 1; i < 8; ++i) if (el[i] > m0) { m0 = el[i]; i0 = i; }
        int i1 = -1; float m1 = -INFINITY;
#pragma unroll
        for (int i = 0; i < 8; ++i) if (i != i0 && el[i] > m1) { m1 = el[i]; i1 = i; }
        const float x1 = __expf(m1 - m0);
        const float gate0 = gprob / (1.f + x1), gate1 = gprob * x1 / (1.f + x1);
        if (lane == 0) {
            const int e0 = gsel * 8 + i0, e1 = gsel * 8 + i1;
            const unsigned r0 = __hip_atomic_fetch_add(lcnt + e0, 1u, __ATOMIC_RELAXED, __HIP_MEMORY_SCOPE_WORKGROUP), r1 = __hip_atomic_fetch_add(lcnt + e1, 1u, __ATOMIC_RELAXED, __HIP_MEMORY_SCOPE_WORKGROUP);
            LAS unsigned* en = lent + ((wid * 10 + kr) * 2) * 4;
            en[0] = (unsigned)e0; en[1] = r0; en[2] = (unsigned)row * 2u; en[3] = __builtin_bit_cast(unsigned, gate0);
            en[4] = (unsigned)e1; en[5] = r1; en[6] = (unsigned)row * 2u + 1u; en[7] = __builtin_bit_cast(unsigned, gate1);
        }
    }
    __syncthreads();
    if (tid < 32) { const unsigned c = lcnt[tid]; lbase[tid] = c ? atomicAdd(cnt + tid, c) : 0u; }
    __syncthreads();
    if (tid < 8 * 10 * 2) {
        const unsigned e = lent[tid * 4];
        if (e != 0xffffffffu) { const unsigned pos = lbase[e] + lent[tid * 4 + 1]; list[e * LIST_CAP + pos] = lent[tid * 4 + 2]; listg[e * LIST_CAP + pos] = __builtin_bit_cast(float, lent[tid * 4 + 3]); }
    }
}

constexpr int MOE_TAB = 131072;
__device__ __forceinline__ void moe_build_table(const unsigned* cnt, LAS int* tab) {
    const int tid = otid();
    __syncthreads();
    if (tid < 32) tab[tid] = (int)cnt[tid];
    __syncthreads();
    if (tid == 0) { int acc = 0; for (int e = 0; e < NEXP; ++e) { tab[32 + e] = acc; acc += (tab[e] + 255) >> 8; } tab[64] = acc; }
    __syncthreads();
}
template <int NT>
__device__ __forceinline__ bool moe_unit(const LAS int* tab, int u, int& e, int& mt, int& nt, int& c, int& hb) {
    const int gt = u / NT; nt = u % NT;
    if (gt >= __builtin_amdgcn_readfirstlane(tab[64])) return false;
    int lo = 0;
#pragma unroll
    for (int s = 16; s > 0; s >>= 1) if (__builtin_amdgcn_readfirstlane(tab[32 + lo + s]) <= gt) lo += s;
    const int t0 = __builtin_amdgcn_readfirstlane(tab[32 + lo]);
    e = lo; mt = gt - t0; c = __builtin_amdgcn_readfirstlane(tab[lo]); hb = t0 * 256;
    return true;
}
__device__ __forceinline__ void phaseE1(const Params& p, int l, LAS char* lds) {
    const int tid1 = otid(), hh = (tid1 & 63) >> 5, wid1 = tid1 >> 6, r32_1 = tid1 & 31;
    const unsigned* cnt = (const unsigned*)(p.ws + WS_CTL) + CW_CNT + l * 64;
    const unsigned* list = (const unsigned*)(p.ws + WS_LIST); const float* listg = (const float*)(p.ws + WS_LISTG);
    const bf16_t* H1b = (const bf16_t*)(p.ws + WS_BF); bf16_t* HID = (bf16_t*)(p.ws + WS_HID);
    LAS int* tab = (LAS int*)(lds + MOE_TAB);
    moe_build_table(cnt, tab);
    unsigned ent[4], nent[4]; float gtv[2], ngt[2];
    auto request = [&](int e, int mt, int c, unsigned (&en)[4], float (&gg)[2]) {
#pragma unroll
        for (int i = 0; i < 4; ++i) { const int idx = mt * 256 + ((tid1 + 512 * i) >> 3); en[i] = list[e * LIST_CAP + (idx < c ? idx : 0)]; }
#pragma unroll
        for (int a = 0; a < 2; ++a) { const int idx = mt * 256 + (wid1 >> 1) * 64 + a * 32 + r32_1; gg[a] = listg[e * LIST_CAP + (idx < c ? idx : 0)]; }
    };
    int u = (gridDim.x == 256) ? (int)(((blockIdx.x & 7) << 5) | (blockIdx.x >> 3)) : (int)blockIdx.x, e, mt, nt, c, hb;
    bool have = moe_unit<4>(tab, u, e, mt, nt, c, hb);
    if (have) request(e, mt, c, ent, gtv);
    while (have) {
        int e2 = 0, mt2 = 0, nt2 = 0, c2 = 0, hb2 = 0;
        const bool have2 = moe_unit<4>(tab, u + (int)gridDim.x, e2, mt2, nt2, c2, hb2);
        if (have2) request(e2, mt2, c2, nent, ngt);
        const bf16_t* ap[4];
#pragma unroll
        for (int i = 0; i < 4; ++i) ap[i] = H1b + (size_t)(ent[i] >> 1) * D + ((tid1 + 512 * i) & 7) * 8;
        auto epi = [&](int mloc, int nloc0, const f32x16& c0, const f32x16& c1) {
            const int idx = mt * 256 + mloc;
            if (idx < c) {
                const float gt = ((mloc >> 5) & 1) ? gtv[1] : gtv[0];
                bf16_t* dst = HID + (size_t)(hb + idx) * DEXP + (nt * 2 + (nloc0 >> 6)) * 32 + 4 * hh;
#pragma unroll
                for (int g = 0; g < 4; ++g) {
                    float h[4];
#pragma unroll
                    for (int j = 0; j < 4; ++j) { const float a = c0[4 * g + j], b = c1[4 * g + j]; h[j] = silu_f(a) * b * gt; }
                    u32x2 o; o.x = pk2(h[0], h[1]); o.y = pk2(h[2], h[3]);
                    *(u32x2*)(dst + 8 * g) = o;
                }
            }
        };
        gemm_tile<2>(lds, ap, (const bf16_t*)(p.ws + WS_W13T) + ((size_t)e * 512 + nt * 128) * D, D, epi);
        u += (int)gridDim.x; have = have2; e = e2; mt = mt2; nt = nt2; c = c2; hb = hb2;
#pragma unroll
        for (int i = 0; i < 4; ++i) ent[i] = nent[i];
        gtv[0] = ngt[0]; gtv[1] = ngt[1];
    }
}

#define XB_TMO      128
#define XB_XCNT(j)  (256  + 64 * (j))
#define XB_XSUB(j)  (1280 + 64 * (j))
#define XB_XGEN(j)  (2304 + 64 * (j))
#define XB_TOP      3328
#define XB_TOPGEN   3392
#define XCD_BAR_WORDS 3456
#define XB_SPIN_CAP (1u << 18)
constexpr int CW_BAR = 4096;
__device__ __forceinline__ unsigned xb_ld(unsigned* p)              { return __hip_atomic_load(p, __ATOMIC_RELAXED, __HIP_MEMORY_SCOPE_AGENT); }
__device__ __forceinline__ unsigned xb_add(unsigned* p, unsigned v) { return __hip_atomic_fetch_add(p, v, __ATOMIC_RELAXED, __HIP_MEMORY_SCOPE_AGENT); }
__device__ __forceinline__ unsigned xb_xcc_id() { return (unsigned)__builtin_amdgcn_s_getreg((3 << 11) | 20) & 0xFu; }
#define XB_SPIN(cond, bar) do { unsigned _sp = 0; while (cond) { __builtin_amdgcn_s_sleep(1); \
    if ((++_sp & 255u) == 0u) { if (xb_ld(&(bar)[XB_TMO])) break; if (_sp > XB_SPIN_CAP) { atomicAdd(&(bar)[XB_TMO], 1u); break; } } } } while (0)
struct XcdBarrier { unsigned* bar; unsigned x; volatile LAS unsigned* st; };
__device__ __forceinline__ XcdBarrier xcd_barrier_post(unsigned* bar, volatile LAS unsigned* st) {
    XcdBarrier b; b.bar = bar; b.x = xb_xcc_id(); b.st = st;
    if (threadIdx.x == 0) (void)xb_add(&bar[XB_XCNT(b.x)], 1u);
    return b;
}
__device__ __forceinline__ void xcd_barrier_complete(unsigned* bar, unsigned x, unsigned& nloc, unsigned& nx) {
    const unsigned G = gridDim.x * gridDim.y * gridDim.z;
    unsigned sum, cnt, mine, sp = 0u;
    for (;;) {
        sum = 0u; cnt = 0u; mine = 0u;
#pragma unroll
        for (unsigned j = 0; j < 16; ++j) { const unsigned c = xb_ld(&bar[XB_XCNT(j)]); sum += c; cnt += (c > 0u) ? 1u : 0u; mine = (j == x) ? c : mine; }
        if (sum == G) break;
        __builtin_amdgcn_s_sleep(1);
        if ((++sp & 255u) == 0u) { if (xb_ld(&bar[XB_TMO])) break; if (sp > XB_SPIN_CAP) { atomicAdd(&bar[XB_TMO], 1u); break; } }
    }
    nloc = mine > 0u ? mine : 1u; nx = cnt > 0u ? cnt : 1u;
}
__device__ __forceinline__ void xcd_barrier(const XcdBarrier& b) {
    asm volatile("s_waitcnt vmcnt(0)" ::: "memory");
    __syncthreads();
    if (threadIdx.x == 0) {
        unsigned* bar = b.bar;
        __builtin_amdgcn_s_waitcnt(0);
        unsigned nloc = b.st[0], nx = b.st[1];
        if (nloc == 0u) { xcd_barrier_complete(bar, b.x, nloc, nx); b.st[0] = nloc; b.st[1] = nx; }
        const unsigned old = xb_add(&bar[XB_XSUB(b.x)], 1u);
        const unsigned gen = old / nloc;
        if (old + 1u == (gen + 1u) * nloc) {
            __builtin_amdgcn_fence(__ATOMIC_RELEASE, "agent");
            asm volatile("s_waitcnt vmcnt(0)" ::: "memory");
            const unsigned og = xb_add(&bar[XB_TOP], 1u);
            const unsigned tg = og / nx;
            if (og + 1u == (tg + 1u) * nx) xb_add(&bar[XB_TOPGEN], 1u);
            else XB_SPIN(xb_ld(&bar[XB_TOPGEN]) == tg, bar);
            __builtin_amdgcn_fence(__ATOMIC_ACQUIRE, "agent");
            xb_add(&bar[XB_XGEN(b.x)], 1u);
            asm volatile("s_waitcnt vmcnt(0)" ::: "memory");
        } else {
            XB_SPIN(xb_ld(&bar[XB_XGEN(b.x)]) == gen, bar);
            __builtin_amdgcn_fence(__ATOMIC_ACQUIRE, "agent");
            asm volatile("s_waitcnt vmcnt(0)" ::: "memory");
        }
    }
    __syncthreads();
}

constexpr int NPHASE = 17;
__global__ void __launch_bounds__(NTHREADS, 2) mega(Params p) {
    extern __shared__ __attribute__((aligned(16))) unsigned char lds_raw[];
    LAS char* lds = (LAS char*)lds_raw;
    volatile LAS unsigned* bst = (volatile LAS unsigned*)(lds + LDS_BYTES - 32);
    if (threadIdx.x < 2) bst[threadIdx.x] = 0u;
    __syncthreads();
    const XcdBarrier xbar = xcd_barrier_post((unsigned*)(p.ws + WS_CTL) + CW_BAR, bst);
    for (int ph = p.ph_lo; ph < p.ph_hi; ++ph) {
        { unsigned la = (unsigned)(uintptr_t)lds; asm volatile("" : "+v"(la)); lds = (LAS char*)(uintptr_t)la; }
        if (ph == 0) phase0(p, lds);
        else {
            const int l = (ph - 1) >> 3, s = (ph - 1) & 7;
            const int nrows = (l == 1) ? NMAIN : NROWS;
            if (s == 0) phaseA(p, l, lds);
            else if (s == 1 || s == 2) phaseB(p, l, s == 2, ph, lds);
            else if (s == 3 || s == 6) phaseCE(p, l, lds, s == 6 ? 1 : 0);
            else if (s == 4) phaseD(p, l, nrows, lds);
            else if (s == 5) phaseE1(p, l, lds);
            else if (s == 7) phaseG(p, l, nrows, l == 1);
        }
        if (ph + 1 < p.ph_hi) xcd_barrier(xbar);
    }
}

extern "C" void kernel_launch(void* const* d_in, const int* in_sizes, int n_in, void* d_out, int out_size, void* d_ws, size_t ws_size, hipStream_t stream) {
    static int grid = 0;
    if (grid == 0) {
        if (n_in != 19 || out_size != NMAIN * D || ws_size < WS_END) { fprintf(stderr, "kernel_launch: unexpected shapes (n_in %d out %d ws %zu)\n", n_in, out_size, ws_size); grid = -1; return; }
        int dev = 0, cus = 0, per_cu = 0;
        hipGetDevice(&dev);
        hipDeviceGetAttribute(&cus, hipDeviceAttributeMultiprocessorCount, dev);
        hipFuncSetAttribute((const void*)mega, hipFuncAttributeMaxDynamicSharedMemorySize, LDS_BYTES);
        hipOccupancyMaxActiveBlocksPerMultiprocessor(&per_cu, (const void*)mega, NTHREADS, LDS_BYTES);
        if (per_cu < 1) { fprintf(stderr, "kernel_launch: occupancy query says %d\n", per_cu); per_cu = 1; }
        (void)hipGetLastError();
        grid = cus;
    }
    if (grid < 0) return;
    hipMemsetAsync((char*)d_ws + WS_CTL, 0, CTL_BYTES, stream);
    Params p{};
    for (int i = 0; i < 19; ++i) p.in[i] = (const float*)d_in[i];
    p.out = (float*)d_out; p.ws = (unsigned char*)d_ws;
    for (int i = 0; i < 32; ++i) p.rope_inv[i] = (float)(1.0 / pow(10000.0, (double)(2 * i) / 64.0));
    p.ph_lo = 0; p.ph_hi = NPHASE;
    void* args[] = {&p};
    hipError_t e = hipLaunchCooperativeKernel((const void*)mega, dim3(grid), dim3(NTHREADS), args, LDS_BYTES, stream);
    if (e != hipSuccess) fprintf(stderr, "cooperative launch failed: %s (grid %d)\n", hipGetErrorString(e), grid);
}
```
